# Optimizing an MI355X kernel written in HIP

```python
import math
import jax, jax.numpy as jnp
from jax import lax
import numpy as np

D_MODEL = 1024
BATCH = 8
SEQ = 4096
DEPTH = 4

N_MIXERS = 3
DA_HEADS = 8
DA_HEAD_DIM = 64
Q_BLOCK = 128
DIL_GROUPS = ((128, 1), (512, 4), (2048, 16))
DIL_HEADS = 8
DIL_HEAD_DIM = 128
DIL_BLOCK = 128
GLA_HEADS = 4
GLA_DK = D_MODEL // 2
GLA_DV = D_MODEL
GLA_GATE_RANK = 16
GLA_TAU = 16.0
GLA_CHUNK = 64
D_FF = 4 * D_MODEL
ALPHA = (2 * DEPTH) ** 0.25
BETA = (8 * DEPTH) ** -0.25
LN_EPS = 1e-5
RMS_EPS = 1e-6

kernel_name = "hybrid_diffattn_dilated_gla_deepnorm"


def layer_norm(x, g, b):
    xf = x.astype(jnp.float32)
    mu = jnp.mean(xf, axis=-1, keepdims=True)
    var = jnp.mean(jnp.square(xf - mu), axis=-1, keepdims=True)
    return ((xf - mu) * lax.rsqrt(var + LN_EPS) * g + b).astype(x.dtype)


def rms_norm(x, g):
    xf = x.astype(jnp.float32)
    return (xf * lax.rsqrt(jnp.mean(xf * xf, axis=-1, keepdims=True) + RMS_EPS) * g).astype(x.dtype)


def alibi_slopes(n_heads):
    return 2.0 ** (-8.0 * jnp.arange(1, n_heads + 1, dtype=jnp.float32) / n_heads)


def diff_lambda_init(layer_idx):
    return 0.8 - 0.6 * math.exp(-0.3 * layer_idx)


def diff_attention(x, w_in, lam_q1, lam_k1, lam_q2, lam_k2, subln_g, w_out, lambda_init):
    B, S, _ = x.shape
    H, d = DA_HEADS, DA_HEAD_DIM
    q, k, v = jnp.split(x @ w_in, 3, axis=-1)
    q = q.reshape(B, S, H, 2, d).transpose(0, 2, 3, 1, 4)
    k = k.reshape(B, S, H, 2, d).transpose(0, 2, 3, 1, 4)
    v = v.reshape(B, S, H, 2 * d).transpose(0, 2, 1, 3)
    lam = (jnp.exp(jnp.sum(lam_q1.astype(jnp.float32) * lam_k1.astype(jnp.float32)))
           - jnp.exp(jnp.sum(lam_q2.astype(jnp.float32) * lam_k2.astype(jnp.float32)))
           + lambda_init)
    slopes = alibi_slopes(H)
    scale = d ** -0.5
    outs = []
    for blk in range(S // Q_BLOCK):
        q0 = blk * Q_BLOCK
        kv_len = q0 + Q_BLOCK
        s = jnp.einsum('bhmqd,bhmkd->bhmqk', q[:, :, :, q0:kv_len],
                       k[:, :, :, :kv_len]).astype(jnp.float32) * scale
        dist = (q0 + jnp.arange(Q_BLOCK))[:, None] - jnp.arange(kv_len)[None, :]
        bias = -slopes[:, None, None] * dist.astype(jnp.float32)
        s = jnp.where(dist >= 0, s + bias[None, :, None], -jnp.inf)
        p = jax.nn.softmax(s, axis=-1)
        a = p[:, :, 0] - lam * p[:, :, 1]
        outs.append(jnp.einsum('bhqk,bhkd->bhqd', a.astype(v.dtype), v[:, :, :kv_len]))
    o = jnp.concatenate(outs, axis=2)
    o = rms_norm(o, subln_g) * (1.0 - lambda_init)
    return o.transpose(0, 2, 1, 3).reshape(B, S, H * 2 * d) @ w_out


def strided_window_attention(q, k, v, window, dil, slopes):
    B, S, H, dh = q.shape
    L = S // dil
    W = window // dil
    BLK = DIL_BLOCK
    nb = -(-L // BLK)
    Lp = nb * BLK

    def to_phase(t):
        t = t.reshape(B, L, dil, H, dh).transpose(0, 2, 3, 1, 4)
        return jnp.pad(t, ((0, 0), (0, 0), (0, 0), (0, Lp - L), (0, 0)))

    def with_prev(t):
        t = jnp.pad(t, ((0, 0), (0, 0), (0, 0), (BLK, 0), (0, 0)))
        prev = t[:, :, :, :Lp].reshape(B, dil, H, nb, BLK, dh)
        cur = t[:, :, :, BLK:].reshape(B, dil, H, nb, BLK, dh)
        return jnp.concatenate([prev, cur], axis=4)

    qb = to_phase(q).reshape(B, dil, H, nb, BLK, dh)
    kb = with_prev(to_phase(k))
    vb = with_prev(to_phase(v))
    s = jnp.einsum('brhnqd,brhnkd->brhnqk', qb, kb).astype(jnp.float32) * (dh ** -0.5)
    qi = jnp.arange(BLK)
    kj = jnp.arange(2 * BLK)
    dist = qi[:, None] + BLK - kj[None, :]
    kpos = jnp.arange(nb)[:, None] * BLK + kj[None, :] - BLK
    valid = ((dist >= 0) & (dist <= W))[None] & (kpos >= 0)[:, None, :]
    bias = -slopes[:, None, None] * (dist * dil).astype(jnp.float32)
    s = jnp.where(valid, s + bias[:, None], -jnp.inf)
    lse = jax.nn.logsumexp(s, axis=-1)
    p = jnp.exp(s - lse[..., None])
    o = jnp.einsum('brhnqk,brhnkd->brhnqd', p.astype(vb.dtype), vb)
    o = o.reshape(B, dil, H, Lp, dh)[:, :, :, :L].transpose(0, 3, 1, 2, 4).reshape(B, S, H, dh)
    lse = lse.reshape(B, dil, H, Lp)[..., :L].transpose(0, 3, 1, 2).reshape(B, S, H)
    return o, lse


def dilated_attention(x, w_in, w_out):
    B, S, _ = x.shape
    H, dh = DIL_HEADS, DIL_HEAD_DIM
    G = len(DIL_GROUPS)
    qkv = (x @ w_in).reshape(B, S, G, 3, H, dh)
    slopes = alibi_slopes(H)
    outs, lses = [], []
    for g, (window, dil) in enumerate(DIL_GROUPS):
        o, lse = strided_window_attention(qkv[:, :, g, 0], qkv[:, :, g, 1], qkv[:, :, g, 2],
                                          window, dil, slopes)
        outs.append(o)
        lses.append(lse)
    wts = jax.nn.softmax(jnp.stack(lses, axis=0), axis=0)
    o = jnp.sum(wts[..., None].astype(x.dtype) * jnp.stack(outs, axis=0), axis=0)
    return o.reshape(B, S, H * dh) @ w_out


def gla_attention(x, w_in, w_gate2, b_gate, gnorm_g, w_out):
    B, S, _ = x.shape
    H, C = GLA_HEADS, GLA_CHUNK
    dk, dv = GLA_DK // H, GLA_DV // H
    nc = S // C
    proj = x @ w_in
    q, k, v, r, g_low = jnp.split(
        proj, [GLA_DK, 2 * GLA_DK, 2 * GLA_DK + GLA_DV, 2 * GLA_DK + 2 * GLA_DV], axis=-1)
    log_a = jax.nn.log_sigmoid((g_low @ w_gate2 + b_gate).astype(jnp.float32)) / GLA_TAU

    def chunked(t, d):
        return t.astype(jnp.float32).reshape(B, nc, C, H, d).transpose(1, 0, 3, 2, 4)

    qc = chunked(q, dk) * (dk ** -0.5)
    kc = chunked(k, dk)
    vc = chunked(v, dv)
    bcum = jnp.cumsum(chunked(log_a, dk), axis=3)
    b_last = bcum[:, :, :, -1:]
    q_dec = qc * jnp.exp(bcum)
    k_intra = kc * jnp.exp(-bcum)
    k_state = kc * jnp.exp(b_last - bcum)
    causal = jnp.tril(jnp.ones((C, C), dtype=bool))
    s = jnp.where(causal, jnp.einsum('nbhqd,nbhkd->nbhqk', q_dec, k_intra), 0.0)
    o_intra = jnp.einsum('nbhqk,nbhkd->nbhqd', s, vc)

    def step(state, inp):
        q_c, k_c, v_c, decay = inp
        o = jnp.einsum('bhqd,bhde->bhqe', q_c, state)
        state = state * decay[:, :, 0, :, None] + jnp.einsum('bhkd,bhke->bhde', k_c, v_c)
        return state, o

    state0 = jnp.zeros((B, H, dk, dv), jnp.float32)
    _, o_inter = lax.scan(step, state0, (q_dec, k_state, vc, jnp.exp(b_last)))
    o = rms_norm(o_intra + o_inter, gnorm_g)
    o = o.transpose(1, 0, 3, 2, 4).reshape(B, S, H * dv).astype(x.dtype)
    o = o * jax.nn.silu(r)
    return o @ w_out


def squared_relu_mlp(x, w1, w2):
    return jnp.square(jax.nn.relu(x @ w1)) @ w2


def setup_inputs(seed: int = 0) -> dict:
    key = jax.random.key(seed)
    keys = iter(jax.random.split(key, 96))

    def dense(fan_in, fan_out, scale=1.0):
        return jax.random.normal(next(keys), (fan_in, fan_out), jnp.float32) * (scale * fan_in ** -0.5)

    def gain(n):
        return 1.0 + 0.02 * jax.random.normal(next(keys), (n,), jnp.float32)

    def small(n, scale=0.02):
        return scale * jax.random.normal(next(keys), (n,), jnp.float32)

    inputs = {"x": jax.random.normal(next(keys), (BATCH, SEQ, D_MODEL), jnp.float32)}
    for i in range(DEPTH):
        p = f"l{i}_"
        kind = i % N_MIXERS
        if kind == 0:
            inputs[p + "w_in"] = dense(D_MODEL, 3 * DA_HEADS * 2 * DA_HEAD_DIM)
            inputs[p + "lam_q1"] = small(DA_HEAD_DIM, 0.1)
            inputs[p + "lam_k1"] = small(DA_HEAD_DIM, 0.1)
            inputs[p + "lam_q2"] = small(DA_HEAD_DIM, 0.1)
            inputs[p + "lam_k2"] = small(DA_HEAD_DIM, 0.1)
            inputs[p + "subln_g"] = gain(2 * DA_HEAD_DIM)
            inputs[p + "w_out"] = dense(DA_HEADS * 2 * DA_HEAD_DIM, D_MODEL, BETA)
        elif kind == 1:
            inputs[p + "w_in"] = dense(D_MODEL, len(DIL_GROUPS) * 3 * DIL_HEADS * DIL_HEAD_DIM)
            inputs[p + "w_out"] = dense(DIL_HEADS * DIL_HEAD_DIM, D_MODEL, BETA)
        else:
            inputs[p + "w_in"] = dense(D_MODEL, 2 * GLA_DK + 2 * GLA_DV + GLA_GATE_RANK)
            inputs[p + "w_gate2"] = dense(GLA_GATE_RANK, GLA_DK)
            inputs[p + "b_gate"] = small(GLA_DK, 0.5)
            inputs[p + "gnorm_g"] = gain(GLA_DV // GLA_HEADS)
            inputs[p + "w_out"] = dense(GLA_DV, D_MODEL, BETA)
        inputs[p + "ln1_g"] = gain(D_MODEL)
        inputs[p + "ln1_b"] = small(D_MODEL)
        inputs[p + "w_ff1"] = dense(D_MODEL, D_FF)
        inputs[p + "w_ff2"] = dense(D_FF, D_MODEL, BETA)
        inputs[p + "ln2_g"] = gain(D_MODEL)
        inputs[p + "ln2_b"] = small(D_MODEL)
    return inputs


def reference(x,
              l0_w_in, l0_lam_q1, l0_lam_k1, l0_lam_q2, l0_lam_k2, l0_subln_g, l0_w_out,
              l0_ln1_g, l0_ln1_b, l0_w_ff1, l0_w_ff2, l0_ln2_g, l0_ln2_b,
              l1_w_in, l1_w_out,
              l1_ln1_g, l1_ln1_b, l1_w_ff1, l1_w_ff2, l1_ln2_g, l1_ln2_b,
              l2_w_in, l2_w_gate2, l2_b_gate, l2_gnorm_g, l2_w_out,
              l2_ln1_g, l2_ln1_b, l2_w_ff1, l2_w_ff2, l2_ln2_g, l2_ln2_b,
              l3_w_in, l3_lam_q1, l3_lam_k1, l3_lam_q2, l3_lam_k2, l3_subln_g, l3_w_out,
              l3_ln1_g, l3_ln1_b, l3_w_ff1, l3_w_ff2, l3_ln2_g, l3_ln2_b):
    layer_params = (
        ((l0_w_in, l0_lam_q1, l0_lam_k1, l0_lam_q2, l0_lam_k2, l0_subln_g, l0_w_out),
         (l0_ln1_g, l0_ln1_b, l0_w_ff1, l0_w_ff2, l0_ln2_g, l0_ln2_b)),
        ((l1_w_in, l1_w_out),
         (l1_ln1_g, l1_ln1_b, l1_w_ff1, l1_w_ff2, l1_ln2_g, l1_ln2_b)),
        ((l2_w_in, l2_w_gate2, l2_b_gate, l2_gnorm_g, l2_w_out),
         (l2_ln1_g, l2_ln1_b, l2_w_ff1, l2_w_ff2, l2_ln2_g, l2_ln2_b)),
        ((l3_w_in, l3_lam_q1, l3_lam_k1, l3_lam_q2, l3_lam_k2, l3_subln_g, l3_w_out),
         (l3_ln1_g, l3_ln1_b, l3_w_ff1, l3_w_ff2, l3_ln2_g, l3_ln2_b)),
    )
    for i in range(DEPTH):
        mix_p, (g1, b1, w1, w2, g2, b2) = layer_params[i]
        kind = i % N_MIXERS
        if kind == 0:
            y = diff_attention(x, *mix_p, lambda_init=diff_lambda_init(i))
        elif kind == 1:
            y = dilated_attention(x, *mix_p)
        else:
            y = gla_attention(x, *mix_p)
        x = layer_norm(ALPHA * x + y, g1, b1)
        x = layer_norm(ALPHA * x + squared_relu_mlp(x, w1, w2), g2, b2)
    return x
```

```cpp
#include <hip/hip_runtime.h>
#include <hip/hip_cooperative_groups.h>
#include <cstdio>
namespace cg = cooperative_groups;

#ifndef MULTI_LAUNCH
#define MULTI_LAUNCH 0
#endif

#define REP_MIXG 1
#define REP_FFN1 1
#define REP_DIL0 1
#define REP_GATE 1
#define REP_SCAN 1
#define REP_DIFF 1
#define REP_PREP 1
#define DI __device__ __forceinline__
#define LAS __attribute__((address_space(3)))
typedef unsigned short bf16_t;
typedef short bf16x8 __attribute__((ext_vector_type(8)));
typedef short s16x4 __attribute__((ext_vector_type(4)));
typedef float f32x2 __attribute__((ext_vector_type(2)));
typedef float f32x4 __attribute__((ext_vector_type(4)));
typedef float f32x16 __attribute__((ext_vector_type(16)));
typedef unsigned u32x2 __attribute__((ext_vector_type(2)));
typedef unsigned u32x4 __attribute__((ext_vector_type(4)));
typedef __bf16 bf2_t __attribute__((ext_vector_type(2)));

constexpr int M_TOK = 32768, DM = 1024, SEQ = 4096, NPH = 35;
constexpr float LOG2E = 1.4426950408889634f;
constexpr float ALPHA_RES = 1.681792830507429f;
constexpr size_t MiB = 1024 * 1024;
constexpr size_t XB_OFF = 0, WB_OFF = 64 * MiB, SCR_OFF = 104 * MiB, BAR_OFF = 491 * MiB, WS_NEED = 492 * MiB;
constexpr int LDS_PHASE_BYTES = 131072, LDS_BYTES = LDS_PHASE_BYTES + 256;

struct Params {
    const float* in[46];
    float* out;
    unsigned char* ws;
    int ph_lo, ph_hi;
};

DI unsigned pk2(float lo, float hi) { f32x2 f = {lo, hi}; bf2_t v = __builtin_convertvector(f, bf2_t); return __builtin_bit_cast(unsigned, v); }
DI bf16_t f2bf(float x) { return (bf16_t)(pk2(x, 0.f) & 0xffffu); }
DI float bf2f(bf16_t v) { return __uint_as_float(((unsigned)v) << 16); }
DI float wave_sum(float v) {
#pragma unroll
    for (int o = 1; o < 64; o <<= 1) v += __shfl_xor(v, o);
    return v;
}
DI int mk_tid(int wv) { int w = wv; asm volatile("" : "+s"(w)); int l = __builtin_amdgcn_mbcnt_hi(~0u, __builtin_amdgcn_mbcnt_lo(~0u, 0u)); asm volatile("" : "+v"(l)); return w * 64 + l; }
DI size_t opq_off(size_t o) { asm volatile("" : "+s"(o)); return o; }
DI int opaque_bid() { int b = blockIdx.x; asm volatile("" : "+s"(b)); return b; }
DI float fexp2(float x) { return __builtin_amdgcn_exp2f(x); }
DI int crow(int i, int hh) { return (i & 3) + 8 * (i >> 2) + 4 * hh; }
#define MFMA32(a, b, c) __builtin_amdgcn_mfma_f32_32x32x16_bf16((a), (b), (c), 0, 0, 0)
DI bf16x8 cat44(s16x4 lo, s16x4 hi) { return __builtin_shufflevector(lo, hi, 0, 1, 2, 3, 4, 5, 6, 7); }
DI bf16x8 pack8(const f32x16& x, int s) {
    u32x4 w;
    w.x = pk2(x[8 * s + 0], x[8 * s + 1]); w.y = pk2(x[8 * s + 2], x[8 * s + 3]);
    w.z = pk2(x[8 * s + 4], x[8 * s + 5]); w.w = pk2(x[8 * s + 6], x[8 * s + 7]);
    return __builtin_bit_cast(bf16x8, w);
}
DI f32x16 zero16() { f32x16 z; for (int i = 0; i < 16; ++i) z[i] = 0.f; return z; }

constexpr int BM = 256, BK = 64, HALF = 128, HTB = HALF * BK * 2, NXCD = 8, WGM = 8;
DI int lds_byte(int r, int c) { const int st = (r >> 4) * 2 + (c >> 5), rr = r & 15, cc = c & 31, ob = rr * 64 + cc * 2; return st * 1024 + (ob ^ (((ob >> 9) & 1) << 5)); }
DI void stage_rc(int b, int& R, int& C) { const int st = b / 1024, sb = b % 1024, swz = sb ^ (((sb >> 9) & 1) << 5); R = (st >> 1) * 16 + swz / 64; C = (st & 1) * 32 + (swz % 64) / 2; }
DI int perm32(int rho) { const int n = rho >> 4, i = rho & 15; return 8 * (i >> 2) + 4 * n + (i & 3); }

struct Unit { int pm, pn; };
struct GemmD { const bf16_t* A; const bf16_t* Bt; int lda, ldb, K, nM, nN, dil, L; };
struct StaticOrder {
    int nM, nN, nwg, G, c;
    DI void init(int nM_, int nN_, int G_, int c_) { nM = nM_; nN = nN_; nwg = nM * nN; G = G_; c = c_; }
    DI bool next(int i, Unit& u) const {
        const long Lx = (long)i * G + c; if (Lx >= nwg) return false;
        int wgid = (int)Lx; { const int q = nwg / NXCD, r = nwg % NXCD, xcd = wgid % NXCD, off = wgid / NXCD; wgid = (xcd < r ? xcd * (q + 1) : r * (q + 1) + (xcd - r) * q) + off; }
        const int nig = WGM * nN, gid = wgid / nig, fm = gid * WGM, gsz = (nM - fm) < WGM ? (nM - fm) : WGM;
        u.pm = fm + ((wgid % nig) % gsz); u.pn = (wgid % nig) / gsz; return true;
    }
};

template <int ACT  > struct EpiBf16 {
    static constexpr bool PERM = true;
    bf16_t* O; size_t ldc;
    DI void operator()(const f32x4 (&acc)[2][2][4][2], const Unit& u, int wr, int wc, int fr, int fq) const {
        const int row0 = u.pm * BM + wr * 64 + fr; const int col0 = u.pn * BM + wc * 32 + 8 * fq;
#pragma unroll
        for (int ai = 0; ai < 2; ++ai)
#pragma unroll
            for (int m = 0; m < 4; ++m) { bf16_t* rowp = O + (size_t)(row0 + ai * HALF + m * 16) * ldc + col0;
#pragma unroll
                for (int bj = 0; bj < 2; ++bj) { f32x4 v0 = acc[ai][bj][m][0], v1 = acc[ai][bj][m][1];
                    if (ACT == 1) {
#pragma unroll
                        for (int j = 0; j < 4; ++j) { float a = fmaxf(v0[j], 0.f), b = fmaxf(v1[j], 0.f); v0[j] = a * a; v1[j] = b * b; } }
                    u32x4 w; w.x = pk2(v0[0], v0[1]); w.y = pk2(v0[2], v0[3]); w.z = pk2(v1[0], v1[1]); w.w = pk2(v1[2], v1[3]);
                    *(u32x4*)(rowp + bj * HALF) = w; } }
    }
};
struct EpiRes {
    static constexpr bool PERM = false;
    const float* res; float* out; const float* st; const float* lg; const float* lb;
    DI void operator()(const f32x4 (&acc)[2][2][4][2], const Unit& u, int wr, int wc, int fr, int fq) const {
        const int row0 = u.pm * BM + wr * 64 + fr, col0 = u.pn * BM + wc * 32 + 4 * fq;
        if (st) {
            f32x4 gv[2][2], bv[2][2];
#pragma unroll
            for (int bj = 0; bj < 2; ++bj)
#pragma unroll
                for (int n = 0; n < 2; ++n) { gv[bj][n] = *(const f32x4*)(lg + col0 + bj * HALF + n * 16); bv[bj][n] = *(const f32x4*)(lb + col0 + bj * HALF + n * 16); }
#pragma unroll
            for (int ai = 0; ai < 2; ++ai)
#pragma unroll
                for (int m = 0; m < 4; ++m) { const int row = row0 + ai * HALF + m * 16; const size_t ro = (size_t)row * DM + col0;
                    const f32x2 ms = *(const f32x2*)(st + 2 * row);
#pragma unroll
                    for (int bj = 0; bj < 2; ++bj)
#pragma unroll
                        for (int n = 0; n < 2; ++n) { const f32x4 r = *(const f32x4*)(res + ro + bj * HALF + n * 16);
                            const f32x4 x = (r - ms.x) * ms.y * gv[bj][n] + bv[bj][n];
                            *(f32x4*)(out + ro + bj * HALF + n * 16) = x * ALPHA_RES + acc[ai][bj][m][n]; } }
        } else {
#pragma unroll
            for (int ai = 0; ai < 2; ++ai)
#pragma unroll
                for (int m = 0; m < 4; ++m) { const size_t ro = (size_t)(row0 + ai * HALF + m * 16) * DM + col0;
#pragma unroll
                    for (int bj = 0; bj < 2; ++bj)
#pragma unroll
                        for (int n = 0; n < 2; ++n) { const f32x4 r = *(const f32x4*)(res + ro + bj * HALF + n * 16);
                            *(f32x4*)(out + ro + bj * HALF + n * 16) = r * ALPHA_RES + acc[ai][bj][m][n]; } }
        }
    }
};

template <class Epi>
DI void gemm_phase(int wv, LAS unsigned char* lds, const GemmD g, const Epi& E) {
    const int tid = mk_tid(wv), wid = __builtin_amdgcn_readfirstlane(tid >> 6), lane = tid & 63, wr = wid >> 2, wc = wid & 3, fr = lane & 15, fq = lane >> 4;
    const int K = g.K, nt = K / BK;
    const int ldbe = g.ldb * g.dil;
    unsigned voffA[2], voffB[2];
#pragma unroll
    for (int i = 0; i < 2; ++i) { int R, C; stage_rc(tid * 16 + i * 8192, R, C); const int Rb = Epi::PERM ? ((R & ~31) + perm32(R & 31)) : R;
        voffA[i] = (unsigned)(R * g.lda + C) * 2u; voffB[i] = (unsigned)(Rb * ldbe + C) * 2u; }
    const size_t kstep = (size_t)(BK * 2);
    const size_t hstepA = (size_t)HALF * g.lda * 2, hstepB = (size_t)HALF * ldbe * 2;
    const unsigned ldsw = (unsigned)wid * 1024u;
    const int aoff = lds_byte(wr * 64 + fr, fq * 8), boff = lds_byte(wc * 32 + fr, fq * 8);
#define PG8_SA(b, h) (((b) * 2 + (h)) * HTB)
#define PG8_SB(b, h) ((4 + (b) * 2 + (h)) * HTB)
#define PG8_STAGE(bufoff, gbase, voff) do { _Pragma("unroll") for (int _i = 0; _i < 2; ++_i) \
        __builtin_amdgcn_global_load_lds((const unsigned*)((const char*)(gbase) + (voff)[_i]), (LAS unsigned*)(lds + (bufoff) + ldsw + _i * 8192), 16, 0, 0); } while (0)
#define PG8_LDA(dst, b, h) do { _Pragma("unroll") for (int m = 0; m < 4; ++m) _Pragma("unroll") for (int k = 0; k < 2; ++k) dst[m][k] = *(const LAS bf16x8*)(lds + PG8_SA(b, h) + aoff + m * 2048 + k * 1024); } while (0)
#define PG8_LDB(dst, b, h) do { _Pragma("unroll") for (int n = 0; n < 2; ++n) _Pragma("unroll") for (int k = 0; k < 2; ++k) dst[n][k] = *(const LAS bf16x8*)(lds + PG8_SB(b, h) + boff + n * 2048 + k * 1024); } while (0)
#define PG8_MMA(ai, bj, At, Bt) do { __builtin_amdgcn_s_setprio(1); _Pragma("unroll") for (int m = 0; m < 4; ++m) _Pragma("unroll") for (int n = 0; n < 2; ++n) _Pragma("unroll") for (int k = 0; k < 2; ++k) \
        acc[ai][bj][m][n] = __builtin_amdgcn_mfma_f32_16x16x32_bf16(Bt[n][k], At[m][k], acc[ai][bj][m][n], 0, 0, 0); __builtin_amdgcn_s_setprio(0); } while (0)
#define PG8_WAIT_V(n) asm volatile("s_waitcnt vmcnt(" #n ")" ::: "memory")
#define PG8_WAIT_L(n) asm volatile("s_waitcnt lgkmcnt(" #n ")" ::: "memory")
#define PG8_BAR __builtin_amdgcn_s_barrier()
#define PG8_SCHED __builtin_amdgcn_sched_barrier(0)
    StaticOrder S; S.init(g.nM, g.nN, (int)gridDim.x, opaque_bid());
    Unit cur, nxt; int ui = 0;
    if (!S.next(0, cur)) return;
    f32x4 acc[2][2][4][2];
#pragma unroll
    for (int a = 0; a < 2; ++a)
#pragma unroll
        for (int b = 0; b < 2; ++b)
#pragma unroll
            for (int m = 0; m < 4; ++m)
#pragma unroll
                for (int n = 0; n < 2; ++n) acc[a][b][m][n] = (f32x4){0.f, 0.f, 0.f, 0.f};
    bf16x8 At[4][2], B0[2][2], B1[2][2];
#define PG8_BROW(pn_) ({ const int p0_ = (pn_) * 256; const int bb_ = p0_ >> 12, rem_ = p0_ & 4095, r_ = rem_ / g.L, l0_ = rem_ - r_ * g.L; (size_t)(bb_ * 4096 + l0_ * g.dil + r_); })
    const char* cA = (const char*)g.A + (size_t)cur.pm * 256 * g.lda * 2; const char* cB = (const char*)g.Bt + PG8_BROW(cur.pn) * (size_t)g.ldb * 2;
    PG8_STAGE(PG8_SB(0, 0), cB, voffB); PG8_STAGE(PG8_SA(0, 0), cA, voffA); PG8_STAGE(PG8_SB(0, 1), cB + hstepB, voffB); PG8_STAGE(PG8_SA(0, 1), cA + hstepA, voffA);
    if (wr == 1) PG8_BAR;
    PG8_WAIT_V(4); PG8_BAR;
    PG8_STAGE(PG8_SB(1, 0), cB + kstep, voffB); PG8_STAGE(PG8_SA(1, 0), cA + kstep, voffA); PG8_STAGE(PG8_SB(1, 1), cB + hstepB + kstep, voffB);
    PG8_WAIT_V(6); PG8_BAR;
    for (;;) {
        const bool has_next = S.next(ui + 1, nxt);
        const char* nA = has_next ? (const char*)g.A + (size_t)nxt.pm * 256 * g.lda * 2 : cA; const char* nB = has_next ? (const char*)g.Bt + PG8_BROW(nxt.pn) * (size_t)g.ldb * 2 : cB;
        for (int t = 0; t < nt; t += 2) {
            const bool last = (t == nt - 2);
            const char* a1 = cA + (size_t)(t + 1) * kstep;
            const char* a2 = last ? nA : cA + (size_t)(t + 2) * kstep; const char* b2 = last ? nB : cB + (size_t)(t + 2) * kstep;
            const char* a3 = a2 + kstep; const char* b3 = b2 + kstep;
            PG8_LDB(B0, 0, 0); PG8_SCHED; PG8_LDA(At, 0, 0); PG8_STAGE(PG8_SA(1, 1), a1 + hstepA, voffA);
            PG8_WAIT_L(8); PG8_BAR; PG8_WAIT_L(0); PG8_MMA(0, 0, At, B0); PG8_BAR; PG8_SCHED;
            PG8_LDB(B1, 0, 1); PG8_STAGE(PG8_SB(0, 0), b2, voffB);
            PG8_BAR; PG8_WAIT_L(0); PG8_MMA(0, 1, At, B1); PG8_BAR;
            PG8_LDA(At, 0, 1); PG8_STAGE(PG8_SA(0, 0), a2, voffA);
            PG8_BAR; PG8_WAIT_L(0); PG8_MMA(1, 0, At, B0); PG8_BAR; PG8_SCHED;
            PG8_STAGE(PG8_SB(0, 1), b2 + hstepB, voffB);
            PG8_WAIT_V(6); PG8_BAR; PG8_MMA(1, 1, At, B1); PG8_BAR;
            PG8_LDB(B0, 1, 0); PG8_SCHED; PG8_LDA(At, 1, 0); PG8_STAGE(PG8_SA(0, 1), a2 + hstepA, voffA);
            PG8_WAIT_L(8); PG8_BAR; PG8_WAIT_L(0); PG8_MMA(0, 0, At, B0); PG8_BAR; PG8_SCHED;
            PG8_LDB(B1, 1, 1); PG8_STAGE(PG8_SB(1, 0), b3, voffB);
            PG8_BAR; PG8_WAIT_L(0); PG8_MMA(0, 1, At, B1); PG8_BAR;
            PG8_LDA(At, 1, 1); PG8_STAGE(PG8_SA(1, 0), a3, voffA);
            PG8_BAR; PG8_WAIT_L(0); PG8_MMA(1, 0, At, B0); PG8_BAR; PG8_SCHED;
            PG8_STAGE(PG8_SB(1, 1), b3 + hstepB, voffB);
            PG8_WAIT_V(6); PG8_BAR; PG8_MMA(1, 1, At, B1); PG8_BAR;
        }
        E(acc, cur, wr, wc, fr, fq);
        if (!has_next) break;
#pragma unroll
        for (int a = 0; a < 2; ++a)
#pragma unroll
            for (int b = 0; b < 2; ++b)
#pragma unroll
                for (int m = 0; m < 4; ++m)
#pragma unroll
                    for (int n = 0; n < 2; ++n) acc[a][b][m][n] = (f32x4){0.f, 0.f, 0.f, 0.f};
        cur = nxt; cA = nA; cB = nB; ++ui;
    }
    PG8_WAIT_V(0);
    if (wr == 0) PG8_BAR;
    PG8_BAR;
#undef PG8_BROW
#undef PG8_SA
#undef PG8_SB
#undef PG8_STAGE
#undef PG8_LDA
#undef PG8_LDB
#undef PG8_MMA
#undef PG8_WAIT_V
#undef PG8_WAIT_L
#undef PG8_BAR
#undef PG8_SCHED
}

DI void transpose_item(const float* W, int K, int ldw, int nblk, bf16_t* WT, LAS float* scr, int item, int lane) {
    const int kb = item / nblk, nb = item % nblk, k0 = 64 * kb, n0 = 32 * nb;
    float wv_[32];
#pragma unroll
    for (int i = 0; i < 32; ++i) { const int kk = 2 * i + (lane >> 5); wv_[i] = W[(size_t)(k0 + kk) * ldw + n0 + (lane & 31)]; }
#pragma unroll
    for (int i = 0; i < 32; ++i) { const int kk = 2 * i + (lane >> 5); scr[kk * 33 + (lane & 31)] = wv_[i]; }
    asm volatile("s_waitcnt lgkmcnt(0)" ::: "memory");
    const int c = lane & 7;
#pragma unroll
    for (int j = 0; j < 4; ++j) { const int n = (lane >> 3) + 8 * j; const LAS float* s = scr + (8 * c) * 33 + n;
        u32x4 o; o.x = pk2(s[0 * 33], s[1 * 33]); o.y = pk2(s[2 * 33], s[3 * 33]); o.z = pk2(s[4 * 33], s[5 * 33]); o.w = pk2(s[6 * 33], s[7 * 33]);
        *(u32x4*)(WT + (size_t)(n0 + n) * K + k0 + 8 * c) = o; }
    asm volatile("s_waitcnt lgkmcnt(0)" ::: "memory");
}
DI int layer_base(int layer) { return layer == 0 ? 1 : layer == 1 ? 14 : layer == 2 ? 22 : 33; }
DI int wout_idx(int layer) { const int kind = layer % 3; return layer_base(layer) + (kind == 0 ? 6 : kind == 1 ? 1 : 4); }
DI void wprep_layer(int wv, LAS unsigned char* lds, const Params& p, int layer, bf16_t* wb) {
    const int kind = layer % 3, nin = kind == 1 ? 9216 : 3072, ldw_in = kind == 1 ? 9216 : kind == 2 ? 3088 : 3072;
    const int wo = wout_idx(layer);
    const float* w_in = p.in[layer_base(layer)]; const float* w_out = p.in[wo]; const float* w1 = p.in[wo + 3]; const float* w2 = p.in[wo + 4];
    bf16_t* wb_out = wb + (size_t)nin * 1024; bf16_t* wb_1 = wb_out + 1024 * 1024; bf16_t* wb_2 = wb_1 + 4096 * 1024;
    const int tid = mk_tid(wv), wid = tid >> 6, lane = tid & 63; const int bid = opaque_bid();
    LAS float* scr = (LAS float*)(lds + wid * 8448);
    const int I0 = 16 * (nin / 32), I1 = 16 * 32, I2 = 16 * 128, I3 = 64 * 32, tot = I0 + I1 + I2 + I3;
    for (int it = bid * 8 + wid; it < tot; it += gridDim.x * 8) {
        int r = it;
        if (r < I0) { transpose_item(w_in, 1024, ldw_in, nin / 32, wb, scr, r, lane); continue; } r -= I0;
        if (r < I1) { transpose_item(w_out, 1024, 1024, 32, wb_out, scr, r, lane); continue; } r -= I1;
        if (r < I2) { transpose_item(w1, 1024, 4096, 128, wb_1, scr, r, lane); continue; } r -= I2;
        transpose_item(w2, 4096, 1024, 32, wb_2, scr, r, lane);
    }
}
DI void xconvert(int wv, const float* x, bf16_t* xb) {
    const size_t n8 = (size_t)M_TOK * DM / 8;
    const size_t st_ = (size_t)gridDim.x * 512;
    for (size_t i = (size_t)opaque_bid() * 512 + mk_tid(wv); i < n8; i += 4 * st_) {
        f32x4 a[4], b[4];
#pragma unroll
        for (int u = 0; u < 4; ++u) { const size_t j = (i + u * st_ < n8) ? i + u * st_ : i; a[u] = ((const f32x4*)x)[2 * j]; b[u] = ((const f32x4*)x)[2 * j + 1]; }
#pragma unroll
        for (int u = 0; u < 4; ++u) if (i + u * st_ < n8) { u32x4 w; w.x = pk2(a[u].x, a[u].y); w.y = pk2(a[u].z, a[u].w); w.z = pk2(b[u].x, b[u].y); w.w = pk2(b[u].z, b[u].w);
            ((u32x4*)xb)[i + u * st_] = w; }
    }
}
DI void ln_phase(int wv, const float* x, float* xo, float* st, const float* g, const float* bta, bf16_t* xb) {
    const int tid = mk_tid(wv), wid = tid >> 6, lane = tid & 63; const int bid = opaque_bid();
    f32x4 gv[4], bv[4];
#pragma unroll
    for (int j = 0; j < 4; ++j) { gv[j] = ((const f32x4*)g)[lane + 64 * j]; bv[j] = ((const f32x4*)bta)[lane + 64 * j]; }
    const int nw = gridDim.x * 8;
    constexpr int R = 4;
    for (int row0 = bid * 8 + wid; row0 < M_TOK; row0 += R * nw) {
        f32x4 v[R][4];
#pragma unroll
        for (int r = 0; r < R; ++r) { const int row = (row0 + r * nw < M_TOK) ? row0 + r * nw : row0;
#pragma unroll
            for (int j = 0; j < 4; ++j) v[r][j] = ((const f32x4*)(x + (size_t)row * DM))[lane + 64 * j]; }
#pragma unroll
        for (int r = 0; r < R; ++r) {
            const int row = row0 + r * nw;
            if (row < M_TOK) {
                float s_ = 0.f;
#pragma unroll
                for (int j = 0; j < 4; ++j) s_ += (v[r][j].x + v[r][j].y) + (v[r][j].z + v[r][j].w);
                const float mean = wave_sum(s_) * (1.f / DM); float s2 = 0.f;
#pragma unroll
                for (int j = 0; j < 4; ++j) { v[r][j] = v[r][j] - mean; s2 += (v[r][j].x * v[r][j].x + v[r][j].y * v[r][j].y) + (v[r][j].z * v[r][j].z + v[r][j].w * v[r][j].w); }
                const float rstd = 1.f / sqrtf(wave_sum(s2) * (1.f / DM) + 1e-5f);
                if (lane == 0) *(f32x2*)(st + 2 * row) = (f32x2){mean, rstd};
                u32x2* o8 = (u32x2*)(xb + (size_t)row * DM) + lane;
#pragma unroll
                for (int j = 0; j < 4; ++j) { const f32x4 y = v[r][j] * rstd * gv[j] + bv[j]; if (xo) ((f32x4*)(xo + (size_t)row * DM) + lane)[64 * j] = y; u32x2 w; w.x = pk2(y.x, y.y); w.y = pk2(y.z, y.w); o8[64 * j] = w; }
            }
        }
    }
}

constexpr int DA_KP = 272, DA_VP = 144, DA_KB = 64 * DA_KP, DA_BUF = DA_KB + 128 * DA_VP;
DI void diff_attn_phase(int wv, LAS unsigned char* lds, const bf16_t* qk, const bf16_t* vt, bf16_t* ob, const float* lq1, const float* lk1, const float* lq2, const float* lk2,
                        const float* subg, int layer_idx) {
    const int tid = mk_tid(wv), wid = __builtin_amdgcn_readfirstlane(tid >> 6), lane = tid & 63, rr = lane & 31, hh = lane >> 5; const int bid = opaque_bid();
    const int map = wid >> 2, qsub = wid & 3;
    int li_ = layer_idx; asm volatile("" : "+s"(li_)); const float lambda_init = (li_ == 0) ? 0.2f : 0.5560582041f;
    const float d1 = wave_sum(lq1[lane] * lk1[lane]), d2 = wave_sum(lq2[lane] * lk2[lane]);
    const float lam = expf(d1) - expf(d2) + lambda_init;
    LAS float* xch = (LAS float*)lds;
    const float c1 = 0.125f * LOG2E;
    const int prr = (rr & 0x13) | ((rr & 4) << 1) | ((rr & 8) >> 1);
    const int koff = prr * DA_KP + (map * 64 + hh * 8) * 2;
    const int voff = DA_KB + rr * DA_VP + hh * 16;
    const int krow0 = tid >> 4, kch = tid & 15, vrow0 = tid >> 3, vch = tid & 7;
    const int kst_off = krow0 * DA_KP + kch * 16, vst_off = DA_KB + vrow0 * DA_VP + vch * 16;
    for (int it = bid; it < 2048; it += gridDim.x) {
        const int rho = it >> 8, j = it & 255, grp = j >> 6, bh = j & 63;
        const int qb = 28 - 4 * rho + ((rho & 1) ? grp : 3 - grp);
        const int b = bh >> 3, hd = bh & 7;
        const int q0 = qb * 128 + qsub * 32, nkt = 2 * qb + 2, qpos = q0 + rr;
        const float slope2 = exp2f(-(float)(hd + 1)) * LOG2E;
        const bf16_t* qkb = qk + (size_t)b * SEQ * 2048;
        bf16x8 qf[4];
#pragma unroll
        for (int ks = 0; ks < 4; ++ks) qf[ks] = *(const bf16x8*)(qkb + (size_t)(q0 + rr) * 2048 + hd * 128 + map * 64 + ks * 16 + hh * 8);
        const bf16_t* kg = qkb + 1024 + hd * 128 + kch * 8 + (size_t)krow0 * 2048;
        const bf16_t* vg = vt + (size_t)(hd * 128 + vrow0) * M_TOK + (size_t)b * SEQ + vch * 8;
        float cb[16];
#pragma unroll
        for (int i = 0; i < 16; ++i) cb[i] = slope2 * (float)((i & 7) + 16 * (i >> 3));
        f32x16 O[4];
#pragma unroll
        for (int d = 0; d < 4; ++d) O[d] = zero16();
        float m = -INFINITY, l = 0.f;
        u32x4 gk[2], gv[2];
#pragma unroll
        for (int i = 0; i < 2; ++i) { gk[i] = *(const u32x4*)(kg + (size_t)i * 32 * 2048); gv[i] = *(const u32x4*)(vg + (size_t)i * 64 * M_TOK); }
#pragma unroll
        for (int i = 0; i < 2; ++i) { *(LAS u32x4*)(lds + kst_off + i * 32 * DA_KP) = gk[i]; *(LAS u32x4*)(lds + vst_off + i * 64 * DA_VP) = gv[i]; }
        __syncthreads();
        for (int t = 0; t < nkt; ++t) {
            const int key0 = t * 64;
            const bool more = (t + 1 < nkt);
            if (more) {
#pragma unroll
                for (int i = 0; i < 2; ++i) { gk[i] = *(const u32x4*)(kg + (size_t)(key0 + 64 + i * 32) * 2048); gv[i] = *(const u32x4*)(vg + (size_t)i * 64 * M_TOK + key0 + 64); } }
            LAS unsigned char* buf = lds + (t & 1) * DA_BUF;
            if (key0 <= q0 + 31) {
                f32x16 S0 = zero16(), S1 = zero16();
                {
                    bf16x8 kf[2][4];
#pragma unroll
                    for (int sub = 0; sub < 2; ++sub)
#pragma unroll
                        for (int ks = 0; ks < 4; ++ks) kf[sub][ks] = *(const LAS bf16x8*)(buf + koff + sub * 32 * DA_KP + ks * 32);
#pragma unroll
                    for (int ks = 0; ks < 4; ++ks) { S0 = MFMA32(kf[0][ks], qf[ks], S0); S1 = MFMA32(kf[1][ks], qf[ks], S1); }
                }
                __builtin_amdgcn_sched_barrier(0);
                bf16x8 vf[4][2];
#pragma unroll
                for (int d = 0; d < 4; ++d)
#pragma unroll
                    for (int s2 = 0; s2 < 2; ++s2) vf[d][s2] = *(const LAS bf16x8*)(buf + voff + d * 32 * DA_VP + (16 * s2) * 2);
                const float base = slope2 * (float)(key0 + 8 * hh - qpos), b32 = 32.f * slope2;
#pragma unroll
                for (int i = 0; i < 16; ++i) { S0[i] = S0[i] * c1 + cb[i]; S1[i] = S1[i] * c1 + cb[i]; }
                if (key0 + 63 > q0) {
                    const int kq = qpos - key0 - 8 * hh;
#pragma unroll
                    for (int i = 0; i < 16; ++i) { const int ko = (i & 7) + 16 * (i >> 3); S0[i] = (ko > kq) ? -INFINITY : S0[i]; S1[i] = (ko + 32 > kq) ? -INFINITY : S1[i]; }
                }
                float mx = -INFINITY, mx1 = -INFINITY;
#pragma unroll
                for (int i = 0; i < 16; ++i) { mx = fmaxf(mx, S0[i]); mx1 = fmaxf(mx1, S1[i]); }
                mx = fmaxf(mx, mx1 + b32) + base;
                mx = fmaxf(mx, __shfl_xor(mx, 32));
                {
                    const float mn = fmaxf(m, mx), alpha = fexp2(m - mn); m = mn; l *= alpha;
#pragma unroll
                    for (int d = 0; d < 4; ++d) O[d] = O[d] * alpha;
                }
                const float off = base - m, off1 = off + b32;
                float ps = 0.f;
#pragma unroll
                for (int i = 0; i < 16; ++i) { S0[i] = fexp2(S0[i] + off); S1[i] = fexp2(S1[i] + off1); ps += S0[i] + S1[i]; }
                l += ps;
                const bf16x8 p0 = pack8(S0, 0), p1 = pack8(S0, 1), p2 = pack8(S1, 0), p3 = pack8(S1, 1);
                __builtin_amdgcn_sched_barrier(0);
#pragma unroll
                for (int d = 0; d < 4; ++d) { O[d] = MFMA32(vf[d][0], p0, O[d]); O[d] = MFMA32(vf[d][1], p1, O[d]); }
                __builtin_amdgcn_sched_barrier(0);
#pragma unroll
                for (int d = 0; d < 4; ++d)
#pragma unroll
                    for (int s2 = 0; s2 < 2; ++s2) vf[d][s2] = *(const LAS bf16x8*)(buf + voff + d * 32 * DA_VP + (32 + 16 * s2) * 2);
#pragma unroll
                for (int d = 0; d < 4; ++d) { O[d] = MFMA32(vf[d][0], p2, O[d]); O[d] = MFMA32(vf[d][1], p3, O[d]); }
            }
            if (more) {
                LAS unsigned char* nb = lds + ((t + 1) & 1) * DA_BUF;
#pragma unroll
                for (int i = 0; i < 2; ++i) { *(LAS u32x4*)(nb + kst_off + i * 32 * DA_KP) = gk[i]; *(LAS u32x4*)(nb + vst_off + i * 64 * DA_VP) = gv[i]; } }
            __syncthreads();
        }
        const float lt = l + __shfl_xor(l, 32), inv = 1.f / lt;
        if (map == 1) { const float f = lam * inv;
#pragma unroll
            for (int d = 0; d < 4; ++d)
#pragma unroll
                for (int i = 0; i < 16; ++i) xch[((qsub * 4 + d) * 16 + i) * 64 + lane] = O[d][i] * f; }
        __syncthreads();
        if (map == 0) {
            float ss = 0.f;
#pragma unroll
            for (int d = 0; d < 4; ++d)
#pragma unroll
                for (int i = 0; i < 16; ++i) { const float o = O[d][i] * inv - xch[((qsub * 4 + d) * 16 + i) * 64 + lane]; O[d][i] = o; ss += o * o; }
            ss += __shfl_xor(ss, 32);
            const float rn = (1.f / sqrtf(ss * (1.f / 128.f) + 1e-6f)) * (1.f - lambda_init);
            bf16_t* orow = ob + (size_t)(b * SEQ + q0 + rr) * 1024 + hd * 128;
#pragma unroll
            for (int d = 0; d < 4; ++d)
#pragma unroll
                for (int gq = 0; gq < 4; ++gq) { const int dv0 = d * 32 + 8 * gq + 4 * hh; const f32x4 g4 = *(const f32x4*)(subg + dv0);
                    u32x2 w; w.x = pk2(O[d][4 * gq] * rn * g4.x, O[d][4 * gq + 1] * rn * g4.y); w.y = pk2(O[d][4 * gq + 2] * rn * g4.z, O[d][4 * gq + 3] * rn * g4.w);
                    *(u32x2*)(orow + dv0) = w; }
        }
        __syncthreads();
    }
}

DI void dil_attn_phase(int wv, const bf16_t* qk, const bf16_t* vt, float* oacc, float* stats, bf16_t* ob, int g, int dil) {
    const int tid = mk_tid(wv), wid = __builtin_amdgcn_readfirstlane(tid >> 6), lane = tid & 63, rr = lane & 31, hh = lane >> 5; const int bid = opaque_bid();
    const int L = SEQ / dil, ntl = L / 32; const int prr = (rr & 0x13) | ((rr & 4) << 1) | ((rr & 8) >> 1);
    const float c1 = 0.08838834764831845f * LOG2E;
    for (int task = bid * 8 + wid; task < 8192; task += gridDim.x * 8) {
        const int lt = task % ntl; int t2 = task / ntl; const int head = t2 & 7; t2 >>= 3; const int rph = t2 % dil, b = t2 / dil;
        const int l0 = lt * 32;
        const float slope2d = exp2f(-(float)(head + 1)) * LOG2E * (float)dil;
        const size_t qrow = (size_t)b * SEQ + (size_t)(l0 + rr) * dil + rph;
        bf16x8 qf[8];
#pragma unroll
        for (int ks = 0; ks < 8; ++ks) qf[ks] = *(const bf16x8*)(qk + qrow * 2048 + head * 128 + ks * 16 + hh * 8);
        f32x16 O[4];
#pragma unroll
        for (int d = 0; d < 4; ++d) O[d] = zero16();
        float m = -INFINITY, l = 0.f;
        for (int jt = 0; jt < 5; ++jt) {
            const int kl0 = l0 - 128 + 32 * jt;
            if (kl0 < 0) continue;
            const size_t krow = (size_t)b * SEQ + (size_t)(kl0 + prr) * dil + rph;
            bf16x8 kf[8];
#pragma unroll
            for (int ks = 0; ks < 8; ++ks) kf[ks] = *(const bf16x8*)(qk + krow * 2048 + 1024 + head * 128 + ks * 16 + hh * 8);
            const bf16_t* vb = vt + (size_t)(head * 128 + rr) * M_TOK + (size_t)b * SEQ + (size_t)rph * L + kl0 + 8 * hh;
            bf16x8 vf[4][2];
#pragma unroll
            for (int d = 0; d < 4; ++d)
#pragma unroll
                for (int s = 0; s < 2; ++s) vf[d][s] = *(const bf16x8*)(vb + (size_t)d * 32 * M_TOK + 16 * s);
            f32x16 S = zero16();
#pragma unroll
            for (int ks = 0; ks < 8; ++ks) S = MFMA32(kf[ks], qf[ks], S);
            float sv[16]; float mx = -INFINITY;
#pragma unroll
            for (int i = 0; i < 16; ++i) { const int dist = (l0 + rr) - (kl0 + (i & 7) + 16 * (i >> 3) + 8 * hh); float v = S[i] * c1 - slope2d * (float)dist; v = (dist >= 0 && dist <= 128) ? v : -INFINITY; sv[i] = v; mx = fmaxf(mx, v); }
            mx = fmaxf(mx, __shfl_xor(mx, 32));
            const float mn = fmaxf(m, mx), alpha = fexp2(m - mn); m = mn;
            float ps = 0.f; f32x16 P;
#pragma unroll
            for (int i = 0; i < 16; ++i) { const float pv = fexp2(sv[i] - mn); P[i] = pv; ps += pv; }
            l = l * alpha + ps;
#pragma unroll
            for (int d = 0; d < 4; ++d) O[d] = O[d] * alpha;
            const bf16x8 pf0 = pack8(P, 0), pf1 = pack8(P, 1);
#pragma unroll
            for (int d = 0; d < 4; ++d) { O[d] = MFMA32(vf[d][0], pf0, O[d]); O[d] = MFMA32(vf[d][1], pf1, O[d]); }
        }
        const float ltot = l + __shfl_xor(l, 32), inv = 1.f / ltot, lse2 = m + log2f(ltot);
        float* st = stats + (qrow * 8 + head) * 2;
        float a = 0.f, bw = 1.f, lrun = 1.f, mrun = lse2;
        if (g > 0) { const float m0 = st[0], lr0 = st[1]; const float mn = fmaxf(m0, lse2); a = fexp2(m0 - mn); bw = fexp2(lse2 - mn); lrun = lr0 * a + bw; mrun = mn; }
        float* orow = oacc + qrow * 1024 + head * 128;
        bf16_t* obrow = ob + qrow * 1024 + head * 128;
        const float f = inv * bw, il = 1.f / lrun;
#pragma unroll
        for (int d = 0; d < 4; ++d)
#pragma unroll
            for (int gq = 0; gq < 4; ++gq) { const int dv0 = d * 32 + 8 * gq + 4 * hh;
                f32x4 o = {O[d][4 * gq] * f, O[d][4 * gq + 1] * f, O[d][4 * gq + 2] * f, O[d][4 * gq + 3] * f};
                if (g > 0) { const f32x4 old = *(const f32x4*)(orow + dv0); o = o + old * a; }
                if (g < 2) *(f32x4*)(orow + dv0) = o;
                else { u32x2 w; w.x = pk2(o.x * il, o.y * il); w.y = pk2(o.z * il, o.w * il); *(u32x2*)(obrow + dv0) = w; } }
        if (g < 2 && hh == 0) { st[0] = mrun; st[1] = lrun; }
    }
}

DI float logsig(float z) { return fminf(z, 0.f) - __logf(1.f + __expf(-fabsf(z))); }
DI void gla_gate_phase(int wv, LAS unsigned char* lds, const float* x, const float* st, const float* lg, const float* lb, const float* w_in, const float* w2, const float* bg, const bf16_t* qk1,
                       bf16_t* qd, bf16_t* ki, bf16_t* kst, float* decay, bf16_t* sbuf) {
    const int tid = mk_tid(wv), wid = tid >> 6, lane = tid & 63, rr = lane & 31, hh = lane >> 5; const int bid = opaque_bid();
    LAS float* wg = (LAS float*)lds;
    LAS float* gl = (LAS float*)(lds + 65536);
#pragma unroll
    for (int i = 0; i < 8; ++i) { const int idx = tid + 512 * i, k = idx >> 2, n4 = (idx & 3) * 4; *(LAS f32x4*)(wg + k * 16 + n4) = *(const f32x4*)(w_in + (size_t)k * 3088 + 3072 + n4); }
    __syncthreads();
    const int c = tid;
    float w2c[16];
#pragma unroll
    for (int j = 0; j < 16; ++j) w2c[j] = w2[j * 512 + c];
    const float bc = bg[c];
    for (int it = bid; it < 512; it += gridDim.x) {
        const int b = it >> 6, ch = it & 63; const size_t T0 = (size_t)b * SEQ + ch * 64;
        for (int tt = 0; tt < 8; tt += 2) {
            const size_t t0 = T0 + wid * 8 + tt;
            const f32x2 ms0 = *(const f32x2*)(st + 2 * t0), ms1 = *(const f32x2*)(st + 2 * (t0 + 1));
            float a0[16], a1[16];
#pragma unroll
            for (int n = 0; n < 16; ++n) { a0[n] = 0.f; a1[n] = 0.f; }
#pragma unroll
            for (int i = 0; i < 16; ++i) { const int k = lane + 64 * i; const float gk_ = lg[k], bk_ = lb[k];
                const float x0 = (x[t0 * DM + k] - ms0.x) * ms0.y * gk_ + bk_, x1 = (x[(t0 + 1) * DM + k] - ms1.x) * ms1.y * gk_ + bk_;
#pragma unroll
                for (int q = 0; q < 4; ++q) { const f32x4 w = *(const LAS f32x4*)(wg + k * 16 + 4 * q);
                    a0[4 * q] += x0 * w.x; a0[4 * q + 1] += x0 * w.y; a0[4 * q + 2] += x0 * w.z; a0[4 * q + 3] += x0 * w.w;
                    a1[4 * q] += x1 * w.x; a1[4 * q + 1] += x1 * w.y; a1[4 * q + 2] += x1 * w.z; a1[4 * q + 3] += x1 * w.w; } }
            float v0 = 0.f, v1 = 0.f;
#pragma unroll
            for (int n = 0; n < 16; ++n) { const float s0 = wave_sum(a0[n]), s1 = wave_sum(a1[n]); v0 = (lane == n) ? s0 : v0; v1 = (lane == n) ? s1 : v1; }
            if (lane < 16) { gl[(wid * 8 + tt) * 16 + lane] = v0; gl[(wid * 8 + tt + 1) * 16 + lane] = v1; }
        }
        __syncthreads();
        bf16_t qa[8], ka[8], qb[8], kb[8];
#define GATE_LOADG(t8, q_, k_) do { _Pragma("unroll") for (int u = 0; u < 8; ++u) { const size_t tok_ = T0 + (t8) + u; q_[u] = qk1[tok_ * 1024 + c]; k_[u] = qk1[tok_ * 1024 + 512 + c]; } } while (0)
        GATE_LOADG(0, qa, ka);
        float cum = 0.f;
#pragma unroll 4
        for (int t = 0; t < 64; ++t) { float z = bc;
#pragma unroll
            for (int q = 0; q < 4; ++q) { const f32x4 gv = *(const LAS f32x4*)(gl + t * 16 + 4 * q); z += gv.x * w2c[4 * q] + gv.y * w2c[4 * q + 1] + gv.z * w2c[4 * q + 2] + gv.w * w2c[4 * q + 3]; }
            cum += logsig(z) * 0.0625f; }
        const float blast = cum;
        decay[((size_t)b * 64 + ch) * 512 + c] = __expf(blast);
        cum = 0.f;
#define GATE_GROUP(t8, q_, k_, nq_, nk_) do { \
            if ((t8) + 8 < 64) GATE_LOADG((t8) + 8, nq_, nk_); \
            float ksv[8]; \
            _Pragma("unroll") for (int u = 0; u < 8; ++u) { const int t = (t8) + u; float z = bc; \
                _Pragma("unroll") for (int q = 0; q < 4; ++q) { const f32x4 gv = *(const LAS f32x4*)(gl + t * 16 + 4 * q); z += gv.x * w2c[4 * q] + gv.y * w2c[4 * q + 1] + gv.z * w2c[4 * q + 2] + gv.w * w2c[4 * q + 3]; } \
                cum += logsig(z) * 0.0625f; \
                const size_t tok = T0 + t; \
                const float qv = bf2f(q_[u]), kv = bf2f(k_[u]); \
                qd[tok * 512 + c] = f2bf(qv * 0.08838834764831845f * __expf(cum)); \
                ki[tok * 512 + c] = f2bf(kv * __expf(-cum)); \
                ksv[u] = kv * __expf(blast - cum); } \
            u32x4 w; w.x = pk2(ksv[0], ksv[1]); w.y = pk2(ksv[2], ksv[3]); w.z = pk2(ksv[4], ksv[5]); w.w = pk2(ksv[6], ksv[7]); \
            *(u32x4*)(kst + ((size_t)b * 512 + c) * SEQ + ch * 64 + (t8)) = w; } while (0)
#pragma nounroll
        for (int t16 = 0; t16 < 64; t16 += 16) { GATE_GROUP(t16, qa, ka, qb, kb); GATE_GROUP(t16 + 8, qb, kb, qa, ka); }
#undef GATE_GROUP
        __syncthreads();
        const int hd = wid >> 1;
#pragma unroll
        for (int u = 0; u < 2; ++u) {
            const int tt2 = (wid & 1) * 2 + u, kt = tt2 >> 1, qt = tt2 & 1;
            f32x16 S = zero16();
            if (!(kt == 1 && qt == 0)) {
#pragma unroll
                for (int ks = 0; ks < 8; ++ks) { const bf16x8 A = *(const bf16x8*)(ki + (T0 + kt * 32 + rr) * 512 + hd * 128 + ks * 16 + hh * 8);
                    const bf16x8 B = *(const bf16x8*)(qd + (T0 + qt * 32 + rr) * 512 + hd * 128 + ks * 16 + hh * 8); S = MFMA32(A, B, S); } }
            const int q = qt * 32 + rr;
            bf16_t* srow = sbuf + (((size_t)b * 4 + hd) * 64 + ch) * 4096 + q * 64 + kt * 32;
#pragma unroll
            for (int gq = 0; gq < 4; ++gq) { const int k0 = 8 * gq + 4 * hh; float v[4];
#pragma unroll
                for (int e = 0; e < 4; ++e) v[e] = (kt * 32 + k0 + e <= q) ? S[4 * gq + e] : 0.f;
                u32x2 w; w.x = pk2(v[0], v[1]); w.y = pk2(v[2], v[3]); *(u32x2*)(srow + k0) = w; }
        }
    }
}
#undef GATE_LOADG
#define SCAN_BAR() do { asm volatile("s_waitcnt lgkmcnt(0)" ::: "memory"); __builtin_amdgcn_s_barrier(); asm volatile("" ::: "memory"); } while (0)
DI void gla_scan_phase(int wv, LAS unsigned char* lds, const bf16_t* qd, const bf16_t* kst, const bf16_t* sbuf, const bf16_t* vt, const float* decay, float* obuf) {
    const int tid = mk_tid(wv), wid = __builtin_amdgcn_readfirstlane(tid >> 6), lane = tid & 63, rr = lane & 31, hh = lane >> 5; const int bid = opaque_bid();
    LAS float* red = (LAS float*)lds;
    for (int task = bid; task < 256; task += gridDim.x) {
        const int dvs = task & 7, hd = (task >> 3) & 3, b = task >> 5;
        const bf16_t* vrow = vt + (size_t)(hd * 256 + dvs * 32) * M_TOK + (size_t)b * SEQ; const unsigned lv = (unsigned)(rr * M_TOK + 8 * hh);
        if (wid < 4) {
            const int kb = wid;
            f32x16 St = zero16();
            const bf16_t* krow = kst + ((size_t)b * 512 + hd * 128 + kb * 32) * SEQ; const unsigned lk = (unsigned)(rr * SEQ + 8 * hh);
            const bf16_t* qp0 = qd + (size_t)b * SEQ * 512 + hd * 128 + kb * 32; const unsigned lq = (unsigned)(rr * 512 + 4 * hh);
            const float* dp0 = decay + (size_t)b * 64 * 512 + hd * 128 + kb * 32; const unsigned ld_ = (unsigned)(4 * hh);
            const int qt = wid >> 1;
            bf16x8 vA[4], kA[4], qB[4]; f32x4 dc[4];
            bf16x8 nvA[4], nkA[4], nqB[4]; f32x4 ndc[4];
#define SCAN_LOADC(c_, vA_, kA_, qB_, dc_) do { \
            _Pragma("unroll") for (int ks = 0; ks < 4; ++ks) { vA_[ks] = *(const bf16x8*)(vrow + (lv + (unsigned)((c_) * 64 + 16 * ks))); kA_[ks] = *(const bf16x8*)(krow + (lk + (unsigned)((c_) * 64 + 16 * ks))); } \
            _Pragma("unroll") for (int s_ = 0; s_ < 2; ++s_) _Pragma("unroll") for (int q_ = 0; q_ < 2; ++q_) { const bf16_t* qp = qp0 + (lq + (unsigned)(((c_) * 64 + q_ * 32) * 512 + 16 * s_)); \
                qB_[2 * s_ + q_] = cat44(*(const s16x4*)qp, *(const s16x4*)(qp + 8)); } \
            _Pragma("unroll") for (int gq = 0; gq < 4; ++gq) dc_[gq] = *(const f32x4*)(dp0 + (ld_ + (unsigned)((c_) * 512 + 8 * gq))); } while (0)
#define SCAN_BODYC(c, vA, kA, qB, dc, nvA, nkA, nqB, ndc) do { \
            const int cn = (c) < 63 ? (c) + 1 : 63; \
            SCAN_LOADC(cn, nvA, nkA, nqB, ndc); \
            LAS float* rb = red + ((c) & 1) * (5 * 2 * 16 * 64); \
            { f32x16 O0 = zero16(), O1 = zero16(); \
              _Pragma("unroll") for (int s_ = 0; s_ < 2; ++s_) { const bf16x8 stA = pack8(St, s_); O0 = MFMA32(stA, qB[2 * s_], O0); O1 = MFMA32(stA, qB[2 * s_ + 1], O1); } \
              LAS float* wp = rb + (wid * 2 * 16) * 64 + lane; \
              _Pragma("unroll") for (int i = 0; i < 16; ++i) { wp[i * 64] = O0[i]; wp[(16 + i) * 64] = O1[i]; } } \
            _Pragma("unroll") for (int gq = 0; gq < 4; ++gq) { St[4 * gq] *= dc[gq].x; St[4 * gq + 1] *= dc[gq].y; St[4 * gq + 2] *= dc[gq].z; St[4 * gq + 3] *= dc[gq].w; } \
            _Pragma("unroll") for (int ks = 0; ks < 4; ++ks) St = MFMA32(kA[ks], vA[ks], St); \
            SCAN_BAR(); \
            { const size_t T0 = (size_t)b * SEQ + (c) * 64; \
              _Pragma("unroll") for (int g2 = 0; g2 < 2; ++g2) { const int gq = 2 * (wid & 1) + g2; f32x4 acc = {0.f, 0.f, 0.f, 0.f}; \
                _Pragma("unroll") for (int sl = 0; sl < 5; ++sl) \
                    _Pragma("unroll") for (int e = 0; e < 4; ++e) acc[e] += rb[((sl * 2 + qt) * 16 + 4 * gq + e) * 64 + lane]; \
                *(f32x4*)(obuf + (T0 + qt * 32 + rr) * 1024 + hd * 256 + dvs * 32 + 8 * gq + 4 * hh) = acc; } } } while (0)
            SCAN_LOADC(0, vA, kA, qB, dc);
#pragma nounroll
            for (int c = 0; c < 64; c += 2) {
                SCAN_BODYC(c, vA, kA, qB, dc, nvA, nkA, nqB, ndc);
                SCAN_BODYC(c + 1, nvA, nkA, nqB, ndc, vA, kA, qB, dc);
            }
#undef SCAN_BODYC
#undef SCAN_LOADC
        } else if (wid == 4) {
            const bf16_t* sb0 = sbuf + ((size_t)b * 4 + hd) * 64 * 4096; const unsigned ls = (unsigned)(rr * 64 + 8 * hh);
            bf16x8 vA[4], sB[6], nvA[4], nsB[6];
#define SCAN_LOADI(c_, vA_, sB_) do { \
            _Pragma("unroll") for (int ks = 0; ks < 4; ++ks) vA_[ks] = *(const bf16x8*)(vrow + (lv + (unsigned)((c_) * 64 + 16 * ks))); \
            _Pragma("unroll") for (int ks = 0; ks < 2; ++ks) sB_[ks] = *(const bf16x8*)(sb0 + (ls + (unsigned)((c_) * 4096 + 16 * ks))); \
            _Pragma("unroll") for (int ks = 0; ks < 4; ++ks) sB_[2 + ks] = *(const bf16x8*)(sb0 + (ls + (unsigned)((c_) * 4096 + 32 * 64 + 16 * ks))); } while (0)
#define SCAN_BODYI(c, vA, sB, nvA, nsB) do { \
            const int cn = (c) < 63 ? (c) + 1 : 63; \
            SCAN_LOADI(cn, nvA, nsB); \
            LAS float* rb = red + ((c) & 1) * (5 * 2 * 16 * 64); \
            f32x16 O0 = zero16(), O1 = zero16(); \
            O0 = MFMA32(vA[0], sB[0], O0); O0 = MFMA32(vA[1], sB[1], O0); \
            _Pragma("unroll") for (int ks = 0; ks < 4; ++ks) O1 = MFMA32(vA[ks], sB[2 + ks], O1); \
            LAS float* wp = rb + (4 * 2 * 16) * 64 + lane; \
            _Pragma("unroll") for (int i = 0; i < 16; ++i) { wp[i * 64] = O0[i]; wp[(16 + i) * 64] = O1[i]; } \
            SCAN_BAR(); } while (0)
            SCAN_LOADI(0, vA, sB);
#pragma nounroll
            for (int c = 0; c < 64; c += 2) {
                SCAN_BODYI(c, vA, sB, nvA, nsB);
                SCAN_BODYI(c + 1, nvA, nsB, vA, sB);
            }
#undef SCAN_BODYI
#undef SCAN_LOADI
        } else {
#pragma nounroll
            for (int c = 0; c < 64; ++c) SCAN_BAR();
        }
        __syncthreads();
    }
}
#undef SCAN_BAR
DI void gla_finish_phase(int wv, const float* obuf, const bf16_t* rb, const float* gn, bf16_t* ob) {
    const int tid = mk_tid(wv), wid = tid >> 6, lane = tid & 63; const int bid = opaque_bid();
    const f32x4 g4 = ((const f32x4*)gn)[lane];
    const int nw = gridDim.x * 8;
    for (int row0 = bid * 8 + wid; row0 < M_TOK; row0 += 2 * nw) {
        f32x4 v[2][4]; u32x2 rw[2][4];
#pragma unroll
        for (int u = 0; u < 2; ++u) { const int row = (row0 + u * nw < M_TOK) ? row0 + u * nw : row0;
#pragma unroll
            for (int i = 0; i < 4; ++i) { v[u][i] = ((const f32x4*)(obuf + (size_t)row * 1024))[lane + 64 * i]; rw[u][i] = ((const u32x2*)(rb + (size_t)row * 1024))[lane + 64 * i]; } }
#pragma unroll
        for (int u = 0; u < 2; ++u) { const int row = row0 + u * nw; if (row < M_TOK) {
#pragma unroll
            for (int i = 0; i < 4; ++i) {
                const f32x4 x = v[u][i];
                const float ss = wave_sum((x.x * x.x + x.y * x.y) + (x.z * x.z + x.w * x.w));
                const float rn = 1.f / sqrtf(ss * (1.f / 256.f) + 1e-6f);
                const u32x2 r_ = rw[u][i];
                const float r0 = __uint_as_float(r_.x << 16), r1 = __uint_as_float(r_.x & 0xffff0000u), r2 = __uint_as_float(r_.y << 16), r3 = __uint_as_float(r_.y & 0xffff0000u);
                const float s0 = r0 / (1.f + expf(-r0)), s1 = r1 / (1.f + expf(-r1)), s2 = r2 / (1.f + expf(-r2)), s3 = r3 / (1.f + expf(-r3));
                u32x2 w; w.x = pk2(x.x * rn * g4.x * s0, x.y * rn * g4.y * s1); w.y = pk2(x.z * rn * g4.z * s2, x.w * rn * g4.w * s3);
                ((u32x2*)(ob + (size_t)row * 1024))[lane + 64 * i] = w;
            } } }
    }
}

DI unsigned xcc_id() { return (unsigned)__builtin_amdgcn_s_getreg((3 << 11) | 20) & 0xFu; }
DI void grid_barrier(int wv, unsigned* bar_, unsigned k, LAS unsigned* stash) {
    unsigned* bar = bar_ + opq_off(0);
    asm volatile("s_waitcnt vmcnt(0) lgkmcnt(0)" ::: "memory");
    __syncthreads();
    if (mk_tid(wv) == 0) {
        const unsigned xcc = xcc_id(), nx = stash[0], nxcc = stash[1];
        const unsigned old = __hip_atomic_fetch_add(bar + 64 * (17 + xcc), 1u, __ATOMIC_RELAXED, __HIP_MEMORY_SCOPE_AGENT);
        if (old == k * nx - 1u) {
            __builtin_amdgcn_fence(__ATOMIC_RELEASE, "agent");
            asm volatile("s_waitcnt vmcnt(0)" ::: "memory");
            const unsigned old2 = __hip_atomic_fetch_add(bar + 64 * 33, 1u, __ATOMIC_RELAXED, __HIP_MEMORY_SCOPE_AGENT);
            if (old2 == k * nxcc - 1u) __hip_atomic_store(bar + 64 * 34, k, __ATOMIC_RELAXED, __HIP_MEMORY_SCOPE_AGENT);
        }
        while (__hip_atomic_load(bar + 64 * 34, __ATOMIC_RELAXED, __HIP_MEMORY_SCOPE_AGENT) < k) __builtin_amdgcn_s_sleep(2);
        __builtin_amdgcn_fence(__ATOMIC_ACQUIRE, "agent");
        asm volatile("s_waitcnt vmcnt(0)" ::: "memory");
    }
    __syncthreads();
}

__global__ void __launch_bounds__(512) mega(Params p) {
    extern __shared__ __attribute__((aligned(16))) unsigned char shm[];
    LAS unsigned char* lds = (LAS unsigned char*)shm;
    cg::grid_group grid = cg::this_grid();
    const int wv = __builtin_amdgcn_readfirstlane((int)threadIdx.x >> 6);
    int ph = 0; unsigned nbar = 0;
    LAS unsigned* stash = (LAS unsigned*)(lds + LDS_PHASE_BYTES);
#define xb ((bf16_t*)(p.ws + opq_off(XB_OFF)))
#define wb ((bf16_t*)(p.ws + opq_off(WB_OFF)))
#define scr (p.ws + opq_off(SCR_OFF))
#define barctr ((unsigned*)(p.ws + opq_off(BAR_OFF)))
#define STT ((float*)(p.ws + opq_off(BAR_OFF + 65536)))
    float* X = p.out;
    if (mk_tid(wv) == 0) __hip_atomic_fetch_add(barctr + 64 * (1 + xcc_id()), 1u, __ATOMIC_RELAXED, __HIP_MEMORY_SCOPE_AGENT);
#define PH_BEGIN if (ph >= p.ph_lo && ph < p.ph_hi) {
#define PH_END   if (ph + 1 < p.ph_hi) { if (ph == p.ph_lo) { grid.sync(); \
        if (mk_tid(wv) == 0) { unsigned nx_ = __hip_atomic_load(barctr + 64 * (1 + xcc_id()), __ATOMIC_RELAXED, __HIP_MEMORY_SCOPE_AGENT), nxcc_ = 0; \
            for (int x_ = 0; x_ < 16; ++x_) nxcc_ += __hip_atomic_load(barctr + 64 * (1 + x_), __ATOMIC_RELAXED, __HIP_MEMORY_SCOPE_AGENT) != 0u ? 1u : 0u; \
            stash[0] = nx_; stash[1] = nxcc_; } } \
        else { ++nbar; grid_barrier(wv, barctr, nbar, stash); } } } ++ph;
    PH_BEGIN
        xconvert(wv, p.in[0], xb);
        wprep_layer(wv, lds, p, 0, wb);
    PH_END
#pragma nounroll
    for (int layer = 0; layer < 4; ++layer) {
        const int kind = layer % 3, ib = layer_base(layer), wo = wout_idx(layer);
        const int nin = kind == 1 ? 9216 : 3072;
        bf16_t* wb_out = wb + (size_t)nin * 1024; bf16_t* wb_1 = wb_out + 1024 * 1024; bf16_t* wb_2 = wb_1 + 4096 * 1024;
        bf16_t* QK = (bf16_t*)scr;
        bf16_t* VT = (bf16_t*)(scr + (kind == 2 ? 192 : 128) * MiB);
        bf16_t* OB = (bf16_t*)(scr + 192 * MiB);
        float* OACC = (float*)(scr + 256 * MiB); float* STATS = (float*)(scr + 384 * MiB);
        bf16_t* KI = (bf16_t*)(scr + 64 * MiB); float* OBUF = (float*)scr; bf16_t* RB = (bf16_t*)(scr + 128 * MiB);
        bf16_t* QD = (bf16_t*)(scr + 256 * MiB); bf16_t* KST = (bf16_t*)(scr + 288 * MiB); bf16_t* SB = (bf16_t*)(scr + 320 * MiB); float* DEC = (float*)(scr + 336 * MiB);
        bf16_t* H = (bf16_t*)scr;
        const int ng = kind == 1 ? 3 : 1;
#pragma nounroll
        for (int g = 0; g < ng; ++g) {
            const int dil = kind == 1 ? (g == 0 ? 1 : g == 1 ? 4 : 16) : 1;
            PH_BEGIN
                const int ngemm = kind == 2 ? 3 : 2;
#pragma nounroll
                for (int rep = 0; rep < REP_MIXG; ++rep)
#pragma nounroll
                for (int gi = 0; gi < ngemm; ++gi) {
                    GemmD d; EpiBf16<0> E;
                    d.K = 1024; d.dil = 1; d.L = 4096;
                    const bf16_t* wg_ = wb + (size_t)g * 3072 * 1024;
                    const bool isvt = (gi == ngemm - 1);
                    if (!isvt) {
                        d.A = xb; d.lda = 1024; d.ldb = 1024; d.nM = 128;
                        if (kind == 2) { d.Bt = wg_ + (size_t)(gi == 0 ? 0 : 2048) * 1024; d.nN = 4; E.O = gi == 0 ? QK : RB; E.ldc = 1024; }
                        else { d.Bt = wg_; d.nN = 8; E.O = QK; E.ldc = 2048; }
                    } else {
                        d.A = wg_ + (size_t)(kind == 2 ? 1024 : 2048) * 1024; d.lda = 1024; d.nM = 4;
                        d.Bt = xb; d.ldb = 1024; d.nN = 128; d.dil = dil; d.L = 4096 / dil; E.O = VT; E.ldc = M_TOK;
                    }
                    gemm_phase(wv, lds, d, E);
                }
            PH_END
            if (kind == 0) {
                PH_BEGIN
                    for (int rep = 0; rep < REP_DIFF; ++rep) diff_attn_phase(wv, lds, QK, VT, OB, p.in[ib + 1], p.in[ib + 2], p.in[ib + 3], p.in[ib + 4], p.in[ib + 5], layer);
                PH_END
            } else if (kind == 1) {
                PH_BEGIN
                    for (int rep = 0; rep < (g == 0 ? REP_DIL0 : 1); ++rep) { if (rep) __syncthreads(); dil_attn_phase(wv, QK, VT, OACC, STATS, OB, g, dil); }
                PH_END
            } else {
                PH_BEGIN
                    for (int rep = 0; rep < REP_GATE; ++rep) { if (rep) __syncthreads(); gla_gate_phase(wv, lds, X, STT, p.in[wout_idx(layer - 1) + 5], p.in[wout_idx(layer - 1) + 6], p.in[ib], p.in[ib + 1], p.in[ib + 2], QK, QD, KI, KST, DEC, SB); }
                PH_END
                PH_BEGIN
                    for (int rep = 0; rep < REP_SCAN; ++rep) gla_scan_phase(wv, lds, QD, KST, SB, VT, DEC, OBUF);
                PH_END
                PH_BEGIN
                    gla_finish_phase(wv, OBUF, RB, p.in[ib + 3], OB);
                PH_END
            }
        }
#pragma nounroll
        for (int sub = 0; sub < 2; ++sub) {
            if (sub == 1) {
                PH_BEGIN
                    GemmD d; EpiBf16<1> E;
                    d.A = xb; d.lda = 1024; d.Bt = wb_1; d.ldb = 1024; d.K = 1024; d.nM = 128; d.nN = 16; d.dil = 1; d.L = 4096; E.O = H; E.ldc = 4096;
#pragma nounroll
                    for (int rep = 0; rep < REP_FFN1; ++rep) gemm_phase(wv, lds, d, E);
                PH_END
            }
            PH_BEGIN
                GemmD d; EpiRes E;
                d.A = sub == 0 ? OB : H; d.lda = sub == 0 ? 1024 : 4096; d.Bt = sub == 0 ? wb_out : wb_2; d.ldb = d.lda; d.K = d.lda; d.nM = 128; d.nN = 4; d.dil = 1; d.L = 4096;
                E.res = (layer == 0 && sub == 0) ? p.in[0] : X; E.out = X;
                E.st = (layer == 0 && sub == 0) ? nullptr : STT;
                { const int wl = sub == 0 ? wout_idx(layer > 0 ? layer - 1 : 0) + 5 : wo + 1; E.lg = p.in[wl]; E.lb = p.in[wl + 1]; }
                gemm_phase(wv, lds, d, E);
            PH_END
            PH_BEGIN
                ln_phase(wv, X, (layer == 3 && sub == 1) ? X : nullptr, STT, p.in[wo + 1 + 4 * sub], p.in[wo + 2 + 4 * sub], xb);
                if (sub == 1 && layer < 3) for (int rep = 0; rep < REP_PREP; ++rep) { if (rep) __syncthreads(); wprep_layer(wv, lds, p, layer + 1, wb); }
            PH_END
        }
    }
}

#undef xb
#undef wb
#undef scr
#undef barctr
#undef STT
extern "C" void kernel_launch(void* const* d_in, const int* in_sizes, int n_in, void* d_out, int out_size, void* d_ws, size_t ws_size, hipStream_t stream) {
    static int grid = 0;
    if (grid == 0) {
        if (n_in != 46 || ws_size < WS_NEED) { fprintf(stderr, "kernel_launch: unexpected n_in %d or ws_size %zu\n", n_in, ws_size); grid = -1; return; }
        int dev = 0, cus = 0, per_cu = 0;
        hipGetDevice(&dev);
        hipDeviceGetAttribute(&cus, hipDeviceAttributeMultiprocessorCount, dev);
        hipFuncSetAttribute((const void*)mega, hipFuncAttributeMaxDynamicSharedMemorySize, LDS_BYTES);
        hipOccupancyMaxActiveBlocksPerMultiprocessor(&per_cu, (const void*)mega, 512, LDS_BYTES);
        if (per_cu < 1) { fprintf(stderr, "kernel_launch: occupancy query says %d blocks per CU\n", per_cu); per_cu = 1; }
        (void)hipGetLastError();
        grid = cus * per_cu;
    }
    if (grid < 0) return;
    Params p{};
    for (int i = 0; i < 46; ++i) p.in[i] = (const float*)d_in[i];
    p.out = (float*)d_out; p.ws = (unsigned char*)d_ws;
#if MULTI_LAUNCH
    for (int ph = 0; ph < NPH; ++ph) { p.ph_lo = ph; p.ph_hi = ph + 1; hipLaunchKernelGGL(mega, dim3(grid), dim3(512), LDS_BYTES, stream, p); }
#else
    p.ph_lo = 0; p.ph_hi = NPH;
    (void)hipMemsetAsync((unsigned char*)d_ws + BAR_OFF, 0, 16384, stream);
    void* args[] = {&p};
    hipError_t e = hipLaunchCooperativeKernel((const void*)mega, dim3(grid), dim3(512), args, LDS_BYTES, stream);
    if (e != hipSuccess) fprintf(stderr, "cooperative launch failed: %s (grid %d)\n", hipGetErrorString(e), grid);
#endif
}
```

```cpp
#include <hip/hip_runtime.h>
#include <hip/hip_cooperative_groups.h>
#include <cstdio>
namespace cg = cooperative_groups;

#ifndef MULTI_LAUNCH
#define MULTI_LAUNCH 0
#endif

#define REP_MIXG 1
#define REP_FFN1 1
#define REP_DIL0 1
#define REP_GATE 1
#define REP_SCAN 1
#define REP_DIFF 1
#define REP_PREP 1
#define DI __device__ __forceinline__
#define LAS __attribute__((address_space(3)))
typedef unsigned short bf16_t;
typedef short bf16x8 __attribute__((ext_vector_type(8)));
typedef short s16x4 __attribute__((ext_vector_type(4)));
typedef float f32x2 __attribute__((ext_vector_type(2)));
typedef float f32x4 __attribute__((ext_vector_type(4)));
typedef float f32x16 __attribute__((ext_vector_type(16)));
typedef unsigned u32x2 __attribute__((ext_vector_type(2)));
typedef unsigned u32x4 __attribute__((ext_vector_type(4)));
typedef __bf16 bf2_t __attribute__((ext_vector_type(2)));

constexpr int M_TOK = 32768, DM = 1024, SEQ = 4096, NPH = 35;
constexpr float LOG2E = 1.4426950408889634f;
constexpr float ALPHA_RES = 1.681792830507429f;
constexpr size_t MiB = 1024 * 1024;
constexpr size_t XB_OFF = 0, WB_OFF = 64 * MiB, SCR_OFF = 104 * MiB, BAR_OFF = 491 * MiB, WS_NEED = 492 * MiB;
constexpr int LDS_PHASE_BYTES = 131072, LDS_BYTES = LDS_PHASE_BYTES + 256;

struct Params {
    const float* in[46];
    float* out;
    unsigned char* ws;
    int ph_lo, ph_hi;
};

DI unsigned pk2(float lo, float hi) { f32x2 f = {lo, hi}; bf2_t v = __builtin_convertvector(f, bf2_t); return __builtin_bit_cast(unsigned, v); }
DI bf16_t f2bf(float x) { return (bf16_t)(pk2(x, 0.f) & 0xffffu); }
DI float bf2f(bf16_t v) { return __uint_as_float(((unsigned)v) << 16); }
DI float wave_sum(float v) {
#pragma unroll
    for (int o = 1; o < 64; o <<= 1) v += __shfl_xor(v, o);
    return v;
}
DI int mk_tid(int wv) { int w = wv; asm volatile("" : "+s"(w)); int l = __builtin_amdgcn_mbcnt_hi(~0u, __builtin_amdgcn_mbcnt_lo(~0u, 0u)); asm volatile("" : "+v"(l)); return w * 64 + l; }
DI unsigned char* opq(unsigned char* p) { asm volatile("" : "+s"(p)); return p; }
DI int opaque_bid() { int b = blockIdx.x; asm volatile("" : "+s"(b)); return b; }
DI float fexp2(float x) { return __builtin_amdgcn_exp2f(x); }
DI int crow(int i, int hh) { return (i & 3) + 8 * (i >> 2) + 4 * hh; }
#define MFMA32(a, b, c) __builtin_amdgcn_mfma_f32_32x32x16_bf16((a), (b), (c), 0, 0, 0)
DI bf16x8 cat44(s16x4 lo, s16x4 hi) { return __builtin_shufflevector(lo, hi, 0, 1, 2, 3, 4, 5, 6, 7); }
DI bf16x8 pack8(const f32x16& x, int s) {
    u32x4 w;
    w.x = pk2(x[8 * s + 0], x[8 * s + 1]); w.y = pk2(x[8 * s + 2], x[8 * s + 3]);
    w.z = pk2(x[8 * s + 4], x[8 * s + 5]); w.w = pk2(x[8 * s + 6], x[8 * s + 7]);
    return __builtin_bit_cast(bf16x8, w);
}
DI f32x16 zero16() { f32x16 z; for (int i = 0; i < 16; ++i) z[i] = 0.f; return z; }

constexpr int BM = 256, BK = 64, HALF = 128, HTB = HALF * BK * 2, NXCD = 8, WGM = 8;
DI int lds_byte(int r, int c) { const int st = (r >> 4) * 2 + (c >> 5), rr = r & 15, cc = c & 31, ob = rr * 64 + cc * 2; return st * 1024 + (ob ^ (((ob >> 9) & 1) << 5)); }
DI void stage_rc(int b, int& R, int& C) { const int st = b / 1024, sb = b % 1024, swz = sb ^ (((sb >> 9) & 1) << 5); R = (st >> 1) * 16 + swz / 64; C = (st & 1) * 32 + (swz % 64) / 2; }
DI int perm32(int rho) { const int n = rho >> 4, i = rho & 15; return 8 * (i >> 2) + 4 * n + (i & 3); }

struct Unit { int pm, pn; };
struct GemmD { const bf16_t* A; const bf16_t* Bt; int lda, ldb, K, nM, nN, dil, L; };
struct StaticOrder {
    int nM, nN, nwg, G, c;
    DI void init(int nM_, int nN_, int G_, int c_) { nM = nM_; nN = nN_; nwg = nM * nN; G = G_; c = c_; }
    DI bool next(int i, Unit& u) const {
        const long Lx = (long)i * G + c; if (Lx >= nwg) return false;
        int wgid = (int)Lx; { const int q = nwg / NXCD, r = nwg % NXCD, xcd = wgid % NXCD, off = wgid / NXCD; wgid = (xcd < r ? xcd * (q + 1) : r * (q + 1) + (xcd - r) * q) + off; }
        const int nig = WGM * nN, gid = wgid / nig, fm = gid * WGM, gsz = (nM - fm) < WGM ? (nM - fm) : WGM;
        u.pm = fm + ((wgid % nig) % gsz); u.pn = (wgid % nig) / gsz; return true;
    }
};

template <int ACT  > struct EpiBf16 {
    static constexpr bool PERM = true;
    bf16_t* O; size_t ldc;
    DI void operator()(const f32x4 (&acc)[2][2][4][2], const Unit& u, int wr, int wc, int fr, int fq) const {
        const int row0 = u.pm * BM + wr * 64 + fr; const int col0 = u.pn * BM + wc * 32 + 8 * fq;
#pragma unroll
        for (int ai = 0; ai < 2; ++ai)
#pragma unroll
            for (int m = 0; m < 4; ++m) { bf16_t* rowp = O + (size_t)(row0 + ai * HALF + m * 16) * ldc + col0;
#pragma unroll
                for (int bj = 0; bj < 2; ++bj) { f32x4 v0 = acc[ai][bj][m][0], v1 = acc[ai][bj][m][1];
                    if (ACT == 1) {
#pragma unroll
                        for (int j = 0; j < 4; ++j) { float a = fmaxf(v0[j], 0.f), b = fmaxf(v1[j], 0.f); v0[j] = a * a; v1[j] = b * b; } }
                    u32x4 w; w.x = pk2(v0[0], v0[1]); w.y = pk2(v0[2], v0[3]); w.z = pk2(v1[0], v1[1]); w.w = pk2(v1[2], v1[3]);
                    *(u32x4*)(rowp + bj * HALF) = w; } }
    }
};
struct EpiRes {
    static constexpr bool PERM = true;
    const bf16_t* res; bf16_t* out;
    DI void operator()(const f32x4 (&acc)[2][2][4][2], const Unit& u, int wr, int wc, int fr, int fq) const {
        const int row0 = u.pm * BM + wr * 64 + fr, col0 = u.pn * BM + wc * 32 + 8 * fq;
#pragma unroll
        for (int ai = 0; ai < 2; ++ai)
#pragma unroll
            for (int m = 0; m < 4; ++m) { const size_t ro = (size_t)(row0 + ai * HALF + m * 16) * DM + col0;
#pragma unroll
                for (int bj = 0; bj < 2; ++bj) { const u32x4 r = *(const u32x4*)(res + ro + bj * HALF);
                    const f32x4 v0 = acc[ai][bj][m][0], v1 = acc[ai][bj][m][1];
                    u32x4 w;
                    w.x = pk2(__uint_as_float(r.x << 16) * ALPHA_RES + v0[0], __uint_as_float(r.x & 0xffff0000u) * ALPHA_RES + v0[1]);
                    w.y = pk2(__uint_as_float(r.y << 16) * ALPHA_RES + v0[2], __uint_as_float(r.y & 0xffff0000u) * ALPHA_RES + v0[3]);
                    w.z = pk2(__uint_as_float(r.z << 16) * ALPHA_RES + v1[0], __uint_as_float(r.z & 0xffff0000u) * ALPHA_RES + v1[1]);
                    w.w = pk2(__uint_as_float(r.w << 16) * ALPHA_RES + v1[2], __uint_as_float(r.w & 0xffff0000u) * ALPHA_RES + v1[3]);
                    *(u32x4*)(out + ro + bj * HALF) = w; } }
    }
};

template <class Epi>
DI void gemm_phase(int wv, LAS unsigned char* lds, const GemmD g, const Epi& E) {
    const int tid = mk_tid(wv), wid = __builtin_amdgcn_readfirstlane(tid >> 6), lane = tid & 63, wr = wid >> 2, wc = wid & 3, fr = lane & 15, fq = lane >> 4;
    const int K = g.K, nt = K / BK;
    const int ldbe = g.ldb * g.dil;
    unsigned voffA[2], voffB[2];
#pragma unroll
    for (int i = 0; i < 2; ++i) { int R, C; stage_rc(tid * 16 + i * 8192, R, C); const int Rb = Epi::PERM ? ((R & ~31) + perm32(R & 31)) : R;
        voffA[i] = (unsigned)(R * g.lda + C) * 2u; voffB[i] = (unsigned)(Rb * ldbe + C) * 2u; }
    const size_t kstep = (size_t)(BK * 2);
    const size_t hstepA = (size_t)HALF * g.lda * 2, hstepB = (size_t)HALF * ldbe * 2;
    const unsigned ldsw = (unsigned)wid * 1024u;
    const int aoff = lds_byte(wr * 64 + fr, fq * 8), boff = lds_byte(wc * 32 + fr, fq * 8);
#define PG8_SA(b, h) (((b) * 2 + (h)) * HTB)
#define PG8_SB(b, h) ((4 + (b) * 2 + (h)) * HTB)
#define PG8_STAGE(bufoff, gbase, voff) do { _Pragma("unroll") for (int _i = 0; _i < 2; ++_i) \
        __builtin_amdgcn_global_load_lds((const unsigned*)((const char*)(gbase) + (voff)[_i]), (LAS unsigned*)(lds + (bufoff) + ldsw + _i * 8192), 16, 0, 0); } while (0)
#define PG8_LDA(dst, b, h) do { _Pragma("unroll") for (int m = 0; m < 4; ++m) _Pragma("unroll") for (int k = 0; k < 2; ++k) dst[m][k] = *(const LAS bf16x8*)(lds + PG8_SA(b, h) + aoff + m * 2048 + k * 1024); } while (0)
#define PG8_LDB(dst, b, h) do { _Pragma("unroll") for (int n = 0; n < 2; ++n) _Pragma("unroll") for (int k = 0; k < 2; ++k) dst[n][k] = *(const LAS bf16x8*)(lds + PG8_SB(b, h) + boff + n * 2048 + k * 1024); } while (0)
#define PG8_MMA(ai, bj, At, Bt) do { __builtin_amdgcn_s_setprio(1); _Pragma("unroll") for (int m = 0; m < 4; ++m) _Pragma("unroll") for (int n = 0; n < 2; ++n) _Pragma("unroll") for (int k = 0; k < 2; ++k) \
        acc[ai][bj][m][n] = __builtin_amdgcn_mfma_f32_16x16x32_bf16(Bt[n][k], At[m][k], acc[ai][bj][m][n], 0, 0, 0); __builtin_amdgcn_s_setprio(0); } while (0)
#define PG8_WAIT_V(n) asm volatile("s_waitcnt vmcnt(" #n ")" ::: "memory")
#define PG8_WAIT_L(n) asm volatile("s_waitcnt lgkmcnt(" #n ")" ::: "memory")
#define PG8_BAR __builtin_amdgcn_s_barrier()
#define PG8_SCHED __builtin_amdgcn_sched_barrier(0)
    StaticOrder S; S.init(g.nM, g.nN, (int)gridDim.x, opaque_bid());
    Unit cur, nxt; int ui = 0;
    if (!S.next(0, cur)) return;
    f32x4 acc[2][2][4][2];
#pragma unroll
    for (int a = 0; a < 2; ++a)
#pragma unroll
        for (int b = 0; b < 2; ++b)
#pragma unroll
            for (int m = 0; m < 4; ++m)
#pragma unroll
                for (int n = 0; n < 2; ++n) acc[a][b][m][n] = (f32x4){0.f, 0.f, 0.f, 0.f};
    bf16x8 At[4][2], B0[2][2], B1[2][2];
#define PG8_BROW(pn_) ({ const int p0_ = (pn_) * 256; const int bb_ = p0_ >> 12, rem_ = p0_ & 4095, r_ = rem_ / g.L, l0_ = rem_ - r_ * g.L; (size_t)(bb_ * 4096 + l0_ * g.dil + r_); })
    const char* cA = (const char*)g.A + (size_t)cur.pm * 256 * g.lda * 2; const char* cB = (const char*)g.Bt + PG8_BROW(cur.pn) * (size_t)g.ldb * 2;
    PG8_STAGE(PG8_SB(0, 0), cB, voffB); PG8_STAGE(PG8_SA(0, 0), cA, voffA); PG8_STAGE(PG8_SB(0, 1), cB + hstepB, voffB); PG8_STAGE(PG8_SA(0, 1), cA + hstepA, voffA);
    if (wr == 1) PG8_BAR;
    PG8_WAIT_V(4); PG8_BAR;
    PG8_STAGE(PG8_SB(1, 0), cB + kstep, voffB); PG8_STAGE(PG8_SA(1, 0), cA + kstep, voffA); PG8_STAGE(PG8_SB(1, 1), cB + hstepB + kstep, voffB);
    PG8_WAIT_V(6); PG8_BAR;
    for (;;) {
        const bool has_next = S.next(ui + 1, nxt);
        const char* nA = has_next ? (const char*)g.A + (size_t)nxt.pm * 256 * g.lda * 2 : cA; const char* nB = has_next ? (const char*)g.Bt + PG8_BROW(nxt.pn) * (size_t)g.ldb * 2 : cB;
        for (int t = 0; t < nt; t += 2) {
            const bool last = (t == nt - 2);
            const char* a1 = cA + (size_t)(t + 1) * kstep;
            const char* a2 = last ? nA : cA + (size_t)(t + 2) * kstep; const char* b2 = last ? nB : cB + (size_t)(t + 2) * kstep;
            const char* a3 = a2 + kstep; const char* b3 = b2 + kstep;
            PG8_LDB(B0, 0, 0); PG8_SCHED; PG8_LDA(At, 0, 0); PG8_STAGE(PG8_SA(1, 1), a1 + hstepA, voffA);
            PG8_WAIT_L(8); PG8_BAR; PG8_WAIT_L(0); PG8_MMA(0, 0, At, B0); PG8_BAR; PG8_SCHED;
            PG8_LDB(B1, 0, 1); PG8_STAGE(PG8_SB(0, 0), b2, voffB);
            PG8_BAR; PG8_WAIT_L(0); PG8_MMA(0, 1, At, B1); PG8_BAR;
            PG8_LDA(At, 0, 1); PG8_STAGE(PG8_SA(0, 0), a2, voffA);
            PG8_BAR; PG8_WAIT_L(0); PG8_MMA(1, 0, At, B0); PG8_BAR; PG8_SCHED;
            PG8_STAGE(PG8_SB(0, 1), b2 + hstepB, voffB);
            PG8_WAIT_V(6); PG8_BAR; PG8_MMA(1, 1, At, B1); PG8_BAR;
            PG8_LDB(B0, 1, 0); PG8_SCHED; PG8_LDA(At, 1, 0); PG8_STAGE(PG8_SA(0, 1), a2 + hstepA, voffA);
            PG8_WAIT_L(8); PG8_BAR; PG8_WAIT_L(0); PG8_MMA(0, 0, At, B0); PG8_BAR; PG8_SCHED;
            PG8_LDB(B1, 1, 1); PG8_STAGE(PG8_SB(1, 0), b3, voffB);
            PG8_BAR; PG8_WAIT_L(0); PG8_MMA(0, 1, At, B1); PG8_BAR;
            PG8_LDA(At, 1, 1); PG8_STAGE(PG8_SA(1, 0), a3, voffA);
            PG8_BAR; PG8_WAIT_L(0); PG8_MMA(1, 0, At, B0); PG8_BAR; PG8_SCHED;
            PG8_STAGE(PG8_SB(1, 1), b3 + hstepB, voffB);
            PG8_WAIT_V(6); PG8_BAR; PG8_MMA(1, 1, At, B1); PG8_BAR;
        }
        E(acc, cur, wr, wc, fr, fq);
        if (!has_next) break;
#pragma unroll
        for (int a = 0; a < 2; ++a)
#pragma unroll
            for (int b = 0; b < 2; ++b)
#pragma unroll
                for (int m = 0; m < 4; ++m)
#pragma unroll
                    for (int n = 0; n < 2; ++n) acc[a][b][m][n] = (f32x4){0.f, 0.f, 0.f, 0.f};
        cur = nxt; cA = nA; cB = nB; ++ui;
    }
    PG8_WAIT_V(0);
    if (wr == 0) PG8_BAR;
    PG8_BAR;
#undef PG8_BROW
#undef PG8_SA
#undef PG8_SB
#undef PG8_STAGE
#undef PG8_LDA
#undef PG8_LDB
#undef PG8_MMA
#undef PG8_WAIT_V
#undef PG8_WAIT_L
#undef PG8_BAR
#undef PG8_SCHED
}

DI void transpose_item(const float* W, int K, int ldw, int nblk, bf16_t* WT, LAS float* scr, int item, int lane) {
    const int kb = item / nblk, nb = item % nblk, k0 = 64 * kb, n0 = 32 * nb;
    float wv_[32];
#pragma unroll
    for (int i = 0; i < 32; ++i) { const int kk = 2 * i + (lane >> 5); wv_[i] = W[(size_t)(k0 + kk) * ldw + n0 + (lane & 31)]; }
#pragma unroll
    for (int i = 0; i < 32; ++i) { const int kk = 2 * i + (lane >> 5); scr[kk * 33 + (lane & 31)] = wv_[i]; }
    asm volatile("s_waitcnt lgkmcnt(0)" ::: "memory");
    const int c = lane & 7;
#pragma unroll
    for (int j = 0; j < 4; ++j) { const int n = (lane >> 3) + 8 * j; const LAS float* s = scr + (8 * c) * 33 + n;
        u32x4 o; o.x = pk2(s[0 * 33], s[1 * 33]); o.y = pk2(s[2 * 33], s[3 * 33]); o.z = pk2(s[4 * 33], s[5 * 33]); o.w = pk2(s[6 * 33], s[7 * 33]);
        *(u32x4*)(WT + (size_t)(n0 + n) * K + k0 + 8 * c) = o; }
    asm volatile("s_waitcnt lgkmcnt(0)" ::: "memory");
}
DI int layer_base(int layer) { return layer == 0 ? 1 : layer == 1 ? 14 : layer == 2 ? 22 : 33; }
DI int wout_idx(int layer) { const int kind = layer % 3; return layer_base(layer) + (kind == 0 ? 6 : kind == 1 ? 1 : 4); }
DI void wprep_layer(int wv, LAS unsigned char* lds, const Params& p, int layer, bf16_t* wb) {
    const int kind = layer % 3, nin = kind == 1 ? 9216 : 3072, ldw_in = kind == 1 ? 9216 : kind == 2 ? 3088 : 3072;
    const int wo = wout_idx(layer);
    const float* w_in = p.in[layer_base(layer)]; const float* w_out = p.in[wo]; const float* w1 = p.in[wo + 3]; const float* w2 = p.in[wo + 4];
    bf16_t* wb_out = wb + (size_t)nin * 1024; bf16_t* wb_1 = wb_out + 1024 * 1024; bf16_t* wb_2 = wb_1 + 4096 * 1024;
    const int tid = mk_tid(wv), wid = tid >> 6, lane = tid & 63; const int bid = opaque_bid();
    LAS float* scr = (LAS float*)(lds + wid * 8448);
    const int I0 = 16 * (nin / 32), I1 = 16 * 32, I2 = 16 * 128, I3 = 64 * 32, tot = I0 + I1 + I2 + I3;
    for (int it = bid * 8 + wid; it < tot; it += gridDim.x * 8) {
        int r = it;
        if (r < I0) { transpose_item(w_in, 1024, ldw_in, nin / 32, wb, scr, r, lane); continue; } r -= I0;
        if (r < I1) { transpose_item(w_out, 1024, 1024, 32, wb_out, scr, r, lane); continue; } r -= I1;
        if (r < I2) { transpose_item(w1, 1024, 4096, 128, wb_1, scr, r, lane); continue; } r -= I2;
        transpose_item(w2, 4096, 1024, 32, wb_2, scr, r, lane);
    }
}
DI void xconvert(int wv, const float* x, bf16_t* xb) {
    const size_t n8 = (size_t)M_TOK * DM / 8;
    const size_t st_ = (size_t)gridDim.x * 512;
    for (size_t i = (size_t)opaque_bid() * 512 + mk_tid(wv); i < n8; i += 4 * st_) {
        f32x4 a[4], b[4];
#pragma unroll
        for (int u = 0; u < 4; ++u) { const size_t j = (i + u * st_ < n8) ? i + u * st_ : i; a[u] = ((const f32x4*)x)[2 * j]; b[u] = ((const f32x4*)x)[2 * j + 1]; }
#pragma unroll
        for (int u = 0; u < 4; ++u) if (i + u * st_ < n8) { u32x4 w; w.x = pk2(a[u].x, a[u].y); w.y = pk2(a[u].z, a[u].w); w.z = pk2(b[u].x, b[u].y); w.w = pk2(b[u].z, b[u].w);
            ((u32x4*)xb)[i + u * st_] = w; }
    }
}
DI void ln_phase(int wv, const bf16_t* y, float* xo, const float* g, const float* bta, bf16_t* xb) {
    const int tid = mk_tid(wv), wid = tid >> 6, lane = tid & 63; const int bid = opaque_bid();
    f32x4 gv[4], bv[4];
#pragma unroll
    for (int j = 0; j < 2; ++j) { gv[2 * j] = *(const f32x4*)(g + j * 512 + lane * 8); gv[2 * j + 1] = *(const f32x4*)(g + j * 512 + lane * 8 + 4);
                                  bv[2 * j] = *(const f32x4*)(bta + j * 512 + lane * 8); bv[2 * j + 1] = *(const f32x4*)(bta + j * 512 + lane * 8 + 4); }
    const int nw = gridDim.x * 8;
    constexpr int R = 4;
    for (int row0 = bid * 8 + wid; row0 < M_TOK; row0 += R * nw) {
        u32x4 raw[R][2];
#pragma unroll
        for (int r = 0; r < R; ++r) { const int row = (row0 + r * nw < M_TOK) ? row0 + r * nw : row0;
#pragma unroll
            for (int j = 0; j < 2; ++j) raw[r][j] = *(const u32x4*)(y + (size_t)row * DM + j * 512 + lane * 8); }
#pragma unroll
        for (int r = 0; r < R; ++r) {
            const int row = row0 + r * nw;
            if (row < M_TOK) {
                f32x4 v[4];
#pragma unroll
                for (int j = 0; j < 2; ++j) { const u32x4 q = raw[r][j];
                    v[2 * j] = (f32x4){__uint_as_float(q.x << 16), __uint_as_float(q.x & 0xffff0000u), __uint_as_float(q.y << 16), __uint_as_float(q.y & 0xffff0000u)};
                    v[2 * j + 1] = (f32x4){__uint_as_float(q.z << 16), __uint_as_float(q.z & 0xffff0000u), __uint_as_float(q.w << 16), __uint_as_float(q.w & 0xffff0000u)}; }
                float s_ = 0.f;
#pragma unroll
                for (int j = 0; j < 4; ++j) s_ += (v[j].x + v[j].y) + (v[j].z + v[j].w);
                const float mean = wave_sum(s_) * (1.f / DM); float s2 = 0.f;
#pragma unroll
                for (int j = 0; j < 4; ++j) { v[j] = v[j] - mean; s2 += (v[j].x * v[j].x + v[j].y * v[j].y) + (v[j].z * v[j].z + v[j].w * v[j].w); }
                const float rstd = 1.f / sqrtf(wave_sum(s2) * (1.f / DM) + 1e-5f);
#pragma unroll
                for (int j = 0; j < 2; ++j) { const f32x4 y0 = v[2 * j] * rstd * gv[2 * j] + bv[2 * j], y1 = v[2 * j + 1] * rstd * gv[2 * j + 1] + bv[2 * j + 1];
                    if (xo) { *(f32x4*)(xo + (size_t)row * DM + j * 512 + lane * 8) = y0; *(f32x4*)(xo + (size_t)row * DM + j * 512 + lane * 8 + 4) = y1; }
                    u32x4 w; w.x = pk2(y0.x, y0.y); w.y = pk2(y0.z, y0.w); w.z = pk2(y1.x, y1.y); w.w = pk2(y1.z, y1.w);
                    *(u32x4*)(xb + (size_t)row * DM + j * 512 + lane * 8) = w; }
            }
        }
    }
}

constexpr int DA_KP = 272, DA_VP = 144, DA_KB = 64 * DA_KP, DA_BUF = DA_KB + 128 * DA_VP;
DI void diff_attn_phase(int wv, LAS unsigned char* lds, const bf16_t* qk, const bf16_t* vt, bf16_t* ob, const float* lq1, const float* lk1, const float* lq2, const float* lk2,
                        const float* subg, int layer_idx) {
    const int tid = mk_tid(wv), wid = __builtin_amdgcn_readfirstlane(tid >> 6), lane = tid & 63, rr = lane & 31, hh = lane >> 5; const int bid = opaque_bid();
    const int map = wid >> 2, qsub = wid & 3;
    int li_ = layer_idx; asm volatile("" : "+s"(li_)); const float lambda_init = (li_ == 0) ? 0.2f : 0.5560582041f;
    const float d1 = wave_sum(lq1[lane] * lk1[lane]), d2 = wave_sum(lq2[lane] * lk2[lane]);
    const float lam = expf(d1) - expf(d2) + lambda_init;
    LAS float* xch = (LAS float*)lds;
    const float c1 = 0.125f * LOG2E;
    const int prr = (rr & 0x13) | ((rr & 4) << 1) | ((rr & 8) >> 1);
    const int koff = prr * DA_KP + (map * 64 + hh * 8) * 2;
    const int voff = DA_KB + rr * DA_VP + hh * 16;
    const int krow0 = tid >> 4, kch = tid & 15, vrow0 = tid >> 3, vch = tid & 7;
    const int kst_off = krow0 * DA_KP + kch * 16, vst_off = DA_KB + vrow0 * DA_VP + vch * 16;
    for (int it = bid; it < 2048; it += gridDim.x) {
        const int rho = it >> 8, j = it & 255, grp = j >> 6, bh = j & 63;
        const int qb = 28 - 4 * rho + ((rho & 1) ? grp : 3 - grp);
        const int b = bh >> 3, hd = bh & 7;
        const int q0 = qb * 128 + qsub * 32, nkt = 2 * qb + 2, qpos = q0 + rr;
        const float slope2 = exp2f(-(float)(hd + 1)) * LOG2E;
        const bf16_t* qkb = qk + (size_t)b * SEQ * 2048;
        bf16x8 qf[4];
#pragma unroll
        for (int ks = 0; ks < 4; ++ks) qf[ks] = *(const bf16x8*)(qkb + (size_t)(q0 + rr) * 2048 + hd * 128 + map * 64 + ks * 16 + hh * 8);
        const bf16_t* kg = qkb + 1024 + hd * 128 + kch * 8 + (size_t)krow0 * 2048;
        const bf16_t* vg = vt + (size_t)(hd * 128 + vrow0) * M_TOK + (size_t)b * SEQ + vch * 8;
        float cb[16];
#pragma unroll
        for (int i = 0; i < 16; ++i) cb[i] = slope2 * (float)((i & 7) + 16 * (i >> 3));
        f32x16 O[4];
#pragma unroll
        for (int d = 0; d < 4; ++d) O[d] = zero16();
        float m = -INFINITY, l = 0.f;
        u32x4 gk[2], gv[2];
#pragma unroll
        for (int i = 0; i < 2; ++i) { gk[i] = *(const u32x4*)(kg + (size_t)i * 32 * 2048); gv[i] = *(const u32x4*)(vg + (size_t)i * 64 * M_TOK); }
#pragma unroll
        for (int i = 0; i < 2; ++i) { *(LAS u32x4*)(lds + kst_off + i * 32 * DA_KP) = gk[i]; *(LAS u32x4*)(lds + vst_off + i * 64 * DA_VP) = gv[i]; }
        __syncthreads();
        for (int t = 0; t < nkt; ++t) {
            const int key0 = t * 64;
            const bool more = (t + 1 < nkt);
            if (more) {
#pragma unroll
                for (int i = 0; i < 2; ++i) { gk[i] = *(const u32x4*)(kg + (size_t)(key0 + 64 + i * 32) * 2048); gv[i] = *(const u32x4*)(vg + (size_t)i * 64 * M_TOK + key0 + 64); } }
            LAS unsigned char* buf = lds + (t & 1) * DA_BUF;
            if (key0 <= q0 + 31) {
                f32x16 S0 = zero16(), S1 = zero16();
                {
                    bf16x8 kf[2][4];
#pragma unroll
                    for (int sub = 0; sub < 2; ++sub)
#pragma unroll
                        for (int ks = 0; ks < 4; ++ks) kf[sub][ks] = *(const LAS bf16x8*)(buf + koff + sub * 32 * DA_KP + ks * 32);
#pragma unroll
                    for (int ks = 0; ks < 4; ++ks) { S0 = MFMA32(kf[0][ks], qf[ks], S0); S1 = MFMA32(kf[1][ks], qf[ks], S1); }
                }
                __builtin_amdgcn_sched_barrier(0);
                bf16x8 vf[4][2];
#pragma unroll
                for (int d = 0; d < 4; ++d)
#pragma unroll
                    for (int s2 = 0; s2 < 2; ++s2) vf[d][s2] = *(const LAS bf16x8*)(buf + voff + d * 32 * DA_VP + (16 * s2) * 2);
                const float base = slope2 * (float)(key0 + 8 * hh - qpos), b32 = 32.f * slope2;
#pragma unroll
                for (int i = 0; i < 16; ++i) { S0[i] = S0[i] * c1 + cb[i]; S1[i] = S1[i] * c1 + cb[i]; }
                if (key0 + 63 > q0) {
                    const int kq = qpos - key0 - 8 * hh;
#pragma unroll
                    for (int i = 0; i < 16; ++i) { const int ko = (i & 7) + 16 * (i >> 3); S0[i] = (ko > kq) ? -INFINITY : S0[i]; S1[i] = (ko + 32 > kq) ? -INFINITY : S1[i]; }
                }
                float mx = -INFINITY, mx1 = -INFINITY;
#pragma unroll
                for (int i = 0; i < 16; ++i) { mx = fmaxf(mx, S0[i]); mx1 = fmaxf(mx1, S1[i]); }
                mx = fmaxf(mx, mx1 + b32) + base;
                mx = fmaxf(mx, __shfl_xor(mx, 32));
                {
                    const float mn = fmaxf(m, mx), alpha = fexp2(m - mn); m = mn; l *= alpha;
#pragma unroll
                    for (int d = 0; d < 4; ++d) O[d] = O[d] * alpha;
                }
                const float off = base - m, off1 = off + b32;
                float ps = 0.f;
#pragma unroll
                for (int i = 0; i < 16; ++i) { S0[i] = fexp2(S0[i] + off); S1[i] = fexp2(S1[i] + off1); ps += S0[i] + S1[i]; }
                l += ps;
                const bf16x8 p0 = pack8(S0, 0), p1 = pack8(S0, 1), p2 = pack8(S1, 0), p3 = pack8(S1, 1);
                __builtin_amdgcn_sched_barrier(0);
#pragma unroll
                for (int d = 0; d < 4; ++d) { O[d] = MFMA32(vf[d][0], p0, O[d]); O[d] = MFMA32(vf[d][1], p1, O[d]); }
                __builtin_amdgcn_sched_barrier(0);
#pragma unroll
                for (int d = 0; d < 4; ++d)
#pragma unroll
                    for (int s2 = 0; s2 < 2; ++s2) vf[d][s2] = *(const LAS bf16x8*)(buf + voff + d * 32 * DA_VP + (32 + 16 * s2) * 2);
#pragma unroll
                for (int d = 0; d < 4; ++d) { O[d] = MFMA32(vf[d][0], p2, O[d]); O[d] = MFMA32(vf[d][1], p3, O[d]); }
            }
            if (more) {
                LAS unsigned char* nb = lds + ((t + 1) & 1) * DA_BUF;
#pragma unroll
                for (int i = 0; i < 2; ++i) { *(LAS u32x4*)(nb + kst_off + i * 32 * DA_KP) = gk[i]; *(LAS u32x4*)(nb + vst_off + i * 64 * DA_VP) = gv[i]; } }
            __syncthreads();
        }
        const float lt = l + __shfl_xor(l, 32), inv = 1.f / lt;
        if (map == 1) { const float f = lam * inv;
#pragma unroll
            for (int d = 0; d < 4; ++d)
#pragma unroll
                for (int i = 0; i < 16; ++i) xch[((qsub * 4 + d) * 16 + i) * 64 + lane] = O[d][i] * f; }
        __syncthreads();
        if (map == 0) {
            float ss = 0.f;
#pragma unroll
            for (int d = 0; d < 4; ++d)
#pragma unroll
                for (int i = 0; i < 16; ++i) { const float o = O[d][i] * inv - xch[((qsub * 4 + d) * 16 + i) * 64 + lane]; O[d][i] = o; ss += o * o; }
            ss += __shfl_xor(ss, 32);
            const float rn = (1.f / sqrtf(ss * (1.f / 128.f) + 1e-6f)) * (1.f - lambda_init);
            bf16_t* orow = ob + (size_t)(b * SEQ + q0 + rr) * 1024 + hd * 128;
#pragma unroll
            for (int d = 0; d < 4; ++d)
#pragma unroll
                for (int gq = 0; gq < 4; ++gq) { const int dv0 = d * 32 + 8 * gq + 4 * hh; const f32x4 g4 = *(const f32x4*)(subg + dv0);
                    u32x2 w; w.x = pk2(O[d][4 * gq] * rn * g4.x, O[d][4 * gq + 1] * rn * g4.y); w.y = pk2(O[d][4 * gq + 2] * rn * g4.z, O[d][4 * gq + 3] * rn * g4.w);
                    *(u32x2*)(orow + dv0) = w; }
        }
        __syncthreads();
    }
}

DI void dil_attn_phase(int wv, const bf16_t* qk, const bf16_t* vt, float* oacc, float* stats, bf16_t* ob, int g, int dil) {
    const int tid = mk_tid(wv), wid = __builtin_amdgcn_readfirstlane(tid >> 6), lane = tid & 63, rr = lane & 31, hh = lane >> 5; const int bid = opaque_bid();
    const int L = SEQ / dil, ntl = L / 32; const int prr = (rr & 0x13) | ((rr & 4) << 1) | ((rr & 8) >> 1);
    const float c1 = 0.08838834764831845f * LOG2E;
    for (int task = bid * 8 + wid; task < 8192; task += gridDim.x * 8) {
        const int lt = task % ntl; int t2 = task / ntl; const int head = t2 & 7; t2 >>= 3; const int rph = t2 % dil, b = t2 / dil;
        const int l0 = lt * 32;
        const float slope2d = exp2f(-(float)(head + 1)) * LOG2E * (float)dil;
        const size_t qrow = (size_t)b * SEQ + (size_t)(l0 + rr) * dil + rph;
        bf16x8 qf[8];
#pragma unroll
        for (int ks = 0; ks < 8; ++ks) qf[ks] = *(const bf16x8*)(qk + qrow * 2048 + head * 128 + ks * 16 + hh * 8);
        f32x16 O[4];
#pragma unroll
        for (int d = 0; d < 4; ++d) O[d] = zero16();
        float m = -INFINITY, l = 0.f;
        for (int jt = 0; jt < 5; ++jt) {
            const int kl0 = l0 - 128 + 32 * jt;
            if (kl0 < 0) continue;
            const size_t krow = (size_t)b * SEQ + (size_t)(kl0 + prr) * dil + rph;
            bf16x8 kf[8];
#pragma unroll
            for (int ks = 0; ks < 8; ++ks) kf[ks] = *(const bf16x8*)(qk + krow * 2048 + 1024 + head * 128 + ks * 16 + hh * 8);
            const bf16_t* vb = vt + (size_t)(head * 128 + rr) * M_TOK + (size_t)b * SEQ + (size_t)rph * L + kl0 + 8 * hh;
            bf16x8 vf[4][2];
#pragma unroll
            for (int d = 0; d < 4; ++d)
#pragma unroll
                for (int s = 0; s < 2; ++s) vf[d][s] = *(const bf16x8*)(vb + (size_t)d * 32 * M_TOK + 16 * s);
            f32x16 S = zero16();
#pragma unroll
            for (int ks = 0; ks < 8; ++ks) S = MFMA32(kf[ks], qf[ks], S);
            float sv[16]; float mx = -INFINITY;
#pragma unroll
            for (int i = 0; i < 16; ++i) { const int dist = (l0 + rr) - (kl0 + (i & 7) + 16 * (i >> 3) + 8 * hh); float v = S[i] * c1 - slope2d * (float)dist; v = (dist >= 0 && dist <= 128) ? v : -INFINITY; sv[i] = v; mx = fmaxf(mx, v); }
            mx = fmaxf(mx, __shfl_xor(mx, 32));
            const float mn = fmaxf(m, mx), alpha = fexp2(m - mn); m = mn;
            float ps = 0.f; f32x16 P;
#pragma unroll
            for (int i = 0; i < 16; ++i) { const float pv = fexp2(sv[i] - mn); P[i] = pv; ps += pv; }
            l = l * alpha + ps;
#pragma unroll
            for (int d = 0; d < 4; ++d) O[d] = O[d] * alpha;
            const bf16x8 pf0 = pack8(P, 0), pf1 = pack8(P, 1);
#pragma unroll
            for (int d = 0; d < 4; ++d) { O[d] = MFMA32(vf[d][0], pf0, O[d]); O[d] = MFMA32(vf[d][1], pf1, O[d]); }
        }
        const float ltot = l + __shfl_xor(l, 32), inv = 1.f / ltot, lse2 = m + log2f(ltot);
        float* st = stats + (qrow * 8 + head) * 2;
        float a = 0.f, bw = 1.f, lrun = 1.f, mrun = lse2;
        if (g > 0) { const float m0 = st[0], lr0 = st[1]; const float mn = fmaxf(m0, lse2); a = fexp2(m0 - mn); bw = fexp2(lse2 - mn); lrun = lr0 * a + bw; mrun = mn; }
        float* orow = oacc + qrow * 1024 + head * 128;
        bf16_t* obrow = ob + qrow * 1024 + head * 128;
        const float f = inv * bw, il = 1.f / lrun;
#pragma unroll
        for (int d = 0; d < 4; ++d)
#pragma unroll
            for (int gq = 0; gq < 4; ++gq) { const int dv0 = d * 32 + 8 * gq + 4 * hh;
                f32x4 o = {O[d][4 * gq] * f, O[d][4 * gq + 1] * f, O[d][4 * gq + 2] * f, O[d][4 * gq + 3] * f};
                if (g > 0) { const f32x4 old = *(const f32x4*)(orow + dv0); o = o + old * a; }
                if (g < 2) *(f32x4*)(orow + dv0) = o;
                else { u32x2 w; w.x = pk2(o.x * il, o.y * il); w.y = pk2(o.z * il, o.w * il); *(u32x2*)(obrow + dv0) = w; } }
        if (g < 2 && hh == 0) { st[0] = mrun; st[1] = lrun; }
    }
}

DI float logsig(float z) { return fminf(z, 0.f) - __logf(1.f + __expf(-fabsf(z))); }
DI void gla_gate_phase(int wv, LAS unsigned char* lds, const float* x, const float* w_in, const float* w2, const float* bg, const bf16_t* qk1,
                       bf16_t* qd, bf16_t* ki, bf16_t* kst, float* decay, bf16_t* sbuf) {
    const int tid = mk_tid(wv), wid = tid >> 6, lane = tid & 63, rr = lane & 31, hh = lane >> 5; const int bid = opaque_bid();
    LAS float* wg = (LAS float*)lds;
    LAS float* gl = (LAS float*)(lds + 65536);
#pragma unroll
    for (int i = 0; i < 8; ++i) { const int idx = tid + 512 * i, k = idx >> 2, n4 = (idx & 3) * 4; *(LAS f32x4*)(wg + k * 16 + n4) = *(const f32x4*)(w_in + (size_t)k * 3088 + 3072 + n4); }
    __syncthreads();
    const int c = tid;
    float w2c[16];
#pragma unroll
    for (int j = 0; j < 16; ++j) w2c[j] = w2[j * 512 + c];
    const float bc = bg[c];
    for (int it = bid; it < 512; it += gridDim.x) {
        const int b = it >> 6, ch = it & 63; const size_t T0 = (size_t)b * SEQ + ch * 64;
        for (int tt = 0; tt < 8; tt += 2) {
            const size_t t0 = T0 + wid * 8 + tt;
            float a0[16], a1[16];
#pragma unroll
            for (int n = 0; n < 16; ++n) { a0[n] = 0.f; a1[n] = 0.f; }
#pragma unroll
            for (int i = 0; i < 16; ++i) { const int k = lane + 64 * i; const float x0 = x[t0 * DM + k], x1 = x[(t0 + 1) * DM + k];
#pragma unroll
                for (int q = 0; q < 4; ++q) { const f32x4 w = *(const LAS f32x4*)(wg + k * 16 + 4 * q);
                    a0[4 * q] += x0 * w.x; a0[4 * q + 1] += x0 * w.y; a0[4 * q + 2] += x0 * w.z; a0[4 * q + 3] += x0 * w.w;
                    a1[4 * q] += x1 * w.x; a1[4 * q + 1] += x1 * w.y; a1[4 * q + 2] += x1 * w.z; a1[4 * q + 3] += x1 * w.w; } }
            float v0 = 0.f, v1 = 0.f;
#pragma unroll
            for (int n = 0; n < 16; ++n) { const float s0 = wave_sum(a0[n]), s1 = wave_sum(a1[n]); v0 = (lane == n) ? s0 : v0; v1 = (lane == n) ? s1 : v1; }
            if (lane < 16) { gl[(wid * 8 + tt) * 16 + lane] = v0; gl[(wid * 8 + tt + 1) * 16 + lane] = v1; }
        }
        __syncthreads();
        float cum = 0.f;
#pragma unroll 4
        for (int t = 0; t < 64; ++t) { float z = bc;
#pragma unroll
            for (int q = 0; q < 4; ++q) { const f32x4 gv = *(const LAS f32x4*)(gl + t * 16 + 4 * q); z += gv.x * w2c[4 * q] + gv.y * w2c[4 * q + 1] + gv.z * w2c[4 * q + 2] + gv.w * w2c[4 * q + 3]; }
            cum += logsig(z) * 0.0625f; }
        const float blast = cum;
        decay[((size_t)b * 64 + ch) * 512 + c] = __expf(blast);
        cum = 0.f;
        for (int t8 = 0; t8 < 64; t8 += 8) {
            float ksv[8];
#pragma unroll
            for (int u = 0; u < 8; ++u) { const int t = t8 + u; float z = bc;
#pragma unroll
                for (int q = 0; q < 4; ++q) { const f32x4 gv = *(const LAS f32x4*)(gl + t * 16 + 4 * q); z += gv.x * w2c[4 * q] + gv.y * w2c[4 * q + 1] + gv.z * w2c[4 * q + 2] + gv.w * w2c[4 * q + 3]; }
                cum += logsig(z) * 0.0625f;
                const size_t tok = T0 + t;
                const float qv = bf2f(qk1[tok * 1024 + c]), kv = bf2f(qk1[tok * 1024 + 512 + c]);
                qd[tok * 512 + c] = f2bf(qv * 0.08838834764831845f * __expf(cum));
                ki[tok * 512 + c] = f2bf(kv * __expf(-cum));
                ksv[u] = kv * __expf(blast - cum); }
            u32x4 w; w.x = pk2(ksv[0], ksv[1]); w.y = pk2(ksv[2], ksv[3]); w.z = pk2(ksv[4], ksv[5]); w.w = pk2(ksv[6], ksv[7]);
            *(u32x4*)(kst + ((size_t)b * 512 + c) * SEQ + ch * 64 + t8) = w;
        }
        __syncthreads();
        const int hd = wid >> 1;
#pragma unroll
        for (int u = 0; u < 2; ++u) {
            const int tt2 = (wid & 1) * 2 + u, kt = tt2 >> 1, qt = tt2 & 1;
            f32x16 S = zero16();
            if (!(kt == 1 && qt == 0)) {
#pragma unroll
                for (int ks = 0; ks < 8; ++ks) { const bf16x8 A = *(const bf16x8*)(ki + (T0 + kt * 32 + rr) * 512 + hd * 128 + ks * 16 + hh * 8);
                    const bf16x8 B = *(const bf16x8*)(qd + (T0 + qt * 32 + rr) * 512 + hd * 128 + ks * 16 + hh * 8); S = MFMA32(A, B, S); } }
            const int q = qt * 32 + rr;
            bf16_t* srow = sbuf + (((size_t)b * 4 + hd) * 64 + ch) * 4096 + q * 64 + kt * 32;
#pragma unroll
            for (int gq = 0; gq < 4; ++gq) { const int k0 = 8 * gq + 4 * hh; float v[4];
#pragma unroll
                for (int e = 0; e < 4; ++e) v[e] = (kt * 32 + k0 + e <= q) ? S[4 * gq + e] : 0.f;
                u32x2 w; w.x = pk2(v[0], v[1]); w.y = pk2(v[2], v[3]); *(u32x2*)(srow + k0) = w; }
        }
    }
}
#define SCAN_BAR() do { asm volatile("s_waitcnt lgkmcnt(0)" ::: "memory"); __builtin_amdgcn_s_barrier(); asm volatile("" ::: "memory"); } while (0)
DI void gla_scan_phase(int wv, LAS unsigned char* lds, const bf16_t* qd, const bf16_t* kst, const bf16_t* sbuf, const bf16_t* vt, const float* decay, float* obuf) {
    const int tid = mk_tid(wv), wid = __builtin_amdgcn_readfirstlane(tid >> 6), lane = tid & 63, rr = lane & 31, hh = lane >> 5; const int bid = opaque_bid();
    LAS float* red = (LAS float*)lds;
    for (int task = bid; task < 256; task += gridDim.x) {
        const int dvs = task & 7, hd = (task >> 3) & 3, b = task >> 5;
        const bf16_t* vrow = vt + (size_t)(hd * 256 + dvs * 32) * M_TOK + (size_t)b * SEQ; const unsigned lv = (unsigned)(rr * M_TOK + 8 * hh);
        if (wid < 4) {
            const int kb = wid;
            f32x16 St = zero16();
            const bf16_t* krow = kst + ((size_t)b * 512 + hd * 128 + kb * 32) * SEQ; const unsigned lk = (unsigned)(rr * SEQ + 8 * hh);
            const bf16_t* qp0 = qd + (size_t)b * SEQ * 512 + hd * 128 + kb * 32; const unsigned lq = (unsigned)(rr * 512 + 4 * hh);
            const float* dp0 = decay + (size_t)b * 64 * 512 + hd * 128 + kb * 32; const unsigned ld_ = (unsigned)(4 * hh);
            const int qt = wid >> 1;
            bf16x8 vA[4], kA[4], qB[4]; f32x4 dc[4];
            bf16x8 nvA[4], nkA[4], nqB[4]; f32x4 ndc[4];
#define SCAN_LOADC(c_, vA_, kA_, qB_, dc_) do { \
            _Pragma("unroll") for (int ks = 0; ks < 4; ++ks) { vA_[ks] = *(const bf16x8*)(vrow + (lv + (unsigned)((c_) * 64 + 16 * ks))); kA_[ks] = *(const bf16x8*)(krow + (lk + (unsigned)((c_) * 64 + 16 * ks))); } \
            _Pragma("unroll") for (int s_ = 0; s_ < 2; ++s_) _Pragma("unroll") for (int q_ = 0; q_ < 2; ++q_) { const bf16_t* qp = qp0 + (lq + (unsigned)(((c_) * 64 + q_ * 32) * 512 + 16 * s_)); \
                qB_[2 * s_ + q_] = cat44(*(const s16x4*)qp, *(const s16x4*)(qp + 8)); } \
            _Pragma("unroll") for (int gq = 0; gq < 4; ++gq) dc_[gq] = *(const f32x4*)(dp0 + (ld_ + (unsigned)((c_) * 512 + 8 * gq))); } while (0)
#define SCAN_BODYC(c, vA, kA, qB, dc, nvA, nkA, nqB, ndc) do { \
            const int cn = (c) < 63 ? (c) + 1 : 63; \
            SCAN_LOADC(cn, nvA, nkA, nqB, ndc); \
            LAS float* rb = red + ((c) & 1) * (5 * 2 * 16 * 64); \
            { f32x16 O0 = zero16(), O1 = zero16(); \
              _Pragma("unroll") for (int s_ = 0; s_ < 2; ++s_) { const bf16x8 stA = pack8(St, s_); O0 = MFMA32(stA, qB[2 * s_], O0); O1 = MFMA32(stA, qB[2 * s_ + 1], O1); } \
              LAS float* wp = rb + (wid * 2 * 16) * 64 + lane; \
              _Pragma("unroll") for (int i = 0; i < 16; ++i) { wp[i * 64] = O0[i]; wp[(16 + i) * 64] = O1[i]; } } \
            _Pragma("unroll") for (int gq = 0; gq < 4; ++gq) { St[4 * gq] *= dc[gq].x; St[4 * gq + 1] *= dc[gq].y; St[4 * gq + 2] *= dc[gq].z; St[4 * gq + 3] *= dc[gq].w; } \
            _Pragma("unroll") for (int ks = 0; ks < 4; ++ks) St = MFMA32(kA[ks], vA[ks], St); \
            SCAN_BAR(); \
            { const size_t T0 = (size_t)b * SEQ + (c) * 64; \
              _Pragma("unroll") for (int g2 = 0; g2 < 2; ++g2) { const int gq = 2 * (wid & 1) + g2; f32x4 acc = {0.f, 0.f, 0.f, 0.f}; \
                _Pragma("unroll") for (int sl = 0; sl < 5; ++sl) \
                    _Pragma("unroll") for (int e = 0; e < 4; ++e) acc[e] += rb[((sl * 2 + qt) * 16 + 4 * gq + e) * 64 + lane]; \
                *(f32x4*)(obuf + (T0 + qt * 32 + rr) * 1024 + hd * 256 + dvs * 32 + 8 * gq + 4 * hh) = acc; } } } while (0)
            SCAN_LOADC(0, vA, kA, qB, dc);
#pragma nounroll
            for (int c = 0; c < 64; c += 2) {
                SCAN_BODYC(c, vA, kA, qB, dc, nvA, nkA, nqB, ndc);
                SCAN_BODYC(c + 1, nvA, nkA, nqB, ndc, vA, kA, qB, dc);
            }
#undef SCAN_BODYC
#undef SCAN_LOADC
        } else if (wid == 4) {
            const bf16_t* sb0 = sbuf + ((size_t)b * 4 + hd) * 64 * 4096; const unsigned ls = (unsigned)(rr * 64 + 8 * hh);
            bf16x8 vA[4], sB[6], nvA[4], nsB[6];
#define SCAN_LOADI(c_, vA_, sB_) do { \
            _Pragma("unroll") for (int ks = 0; ks < 4; ++ks) vA_[ks] = *(const bf16x8*)(vrow + (lv + (unsigned)((c_) * 64 + 16 * ks))); \
            _Pragma("unroll") for (int ks = 0; ks < 2; ++ks) sB_[ks] = *(const bf16x8*)(sb0 + (ls + (unsigned)((c_) * 4096 + 16 * ks))); \
            _Pragma("unroll") for (int ks = 0; ks < 4; ++ks) sB_[2 + ks] = *(const bf16x8*)(sb0 + (ls + (unsigned)((c_) * 4096 + 32 * 64 + 16 * ks))); } while (0)
#define SCAN_BODYI(c, vA, sB, nvA, nsB) do { \
            const int cn = (c) < 63 ? (c) + 1 : 63; \
            SCAN_LOADI(cn, nvA, nsB); \
            LAS float* rb = red + ((c) & 1) * (5 * 2 * 16 * 64); \
            f32x16 O0 = zero16(), O1 = zero16(); \
            O0 = MFMA32(vA[0], sB[0], O0); O0 = MFMA32(vA[1], sB[1], O0); \
            _Pragma("unroll") for (int ks = 0; ks < 4; ++ks) O1 = MFMA32(vA[ks], sB[2 + ks], O1); \
            LAS float* wp = rb + (4 * 2 * 16) * 64 + lane; \
            _Pragma("unroll") for (int i = 0; i < 16; ++i) { wp[i * 64] = O0[i]; wp[(16 + i) * 64] = O1[i]; } \
            SCAN_BAR(); } while (0)
            SCAN_LOADI(0, vA, sB);
#pragma nounroll
            for (int c = 0; c < 64; c += 2) {
                SCAN_BODYI(c, vA, sB, nvA, nsB);
                SCAN_BODYI(c + 1, nvA, nsB, vA, sB);
            }
#undef SCAN_BODYI
#undef SCAN_LOADI
        } else {
#pragma nounroll
            for (int c = 0; c < 64; ++c) SCAN_BAR();
        }
        __syncthreads();
    }
}
#undef SCAN_BAR
DI void gla_finish_phase(int wv, const float* obuf, const bf16_t* rb, const float* gn, bf16_t* ob) {
    const int tid = mk_tid(wv), wid = tid >> 6, lane = tid & 63; const int bid = opaque_bid();
    const f32x4 g4 = ((const f32x4*)gn)[lane];
    const int nw = gridDim.x * 8;
    for (int row0 = bid * 8 + wid; row0 < M_TOK; row0 += 2 * nw) {
        f32x4 v[2][4]; u32x2 rw[2][4];
#pragma unroll
        for (int u = 0; u < 2; ++u) { const int row = (row0 + u * nw < M_TOK) ? row0 + u * nw : row0;
#pragma unroll
            for (int i = 0; i < 4; ++i) { v[u][i] = ((const f32x4*)(obuf + (size_t)row * 1024))[lane + 64 * i]; rw[u][i] = ((const u32x2*)(rb + (size_t)row * 1024))[lane + 64 * i]; } }
#pragma unroll
        for (int u = 0; u < 2; ++u) { const int row = row0 + u * nw; if (row < M_TOK) {
#pragma unroll
            for (int i = 0; i < 4; ++i) {
                const f32x4 x = v[u][i];
                const float ss = wave_sum((x.x * x.x + x.y * x.y) + (x.z * x.z + x.w * x.w));
                const float rn = 1.f / sqrtf(ss * (1.f / 256.f) + 1e-6f);
                const u32x2 r_ = rw[u][i];
                const float r0 = __uint_as_float(r_.x << 16), r1 = __uint_as_float(r_.x & 0xffff0000u), r2 = __uint_as_float(r_.y << 16), r3 = __uint_as_float(r_.y & 0xffff0000u);
                const float s0 = r0 / (1.f + expf(-r0)), s1 = r1 / (1.f + expf(-r1)), s2 = r2 / (1.f + expf(-r2)), s3 = r3 / (1.f + expf(-r3));
                u32x2 w; w.x = pk2(x.x * rn * g4.x * s0, x.y * rn * g4.y * s1); w.y = pk2(x.z * rn * g4.z * s2, x.w * rn * g4.w * s3);
                ((u32x2*)(ob + (size_t)row * 1024))[lane + 64 * i] = w;
            } } }
    }
}

DI unsigned xcc_id() { return (unsigned)__builtin_amdgcn_s_getreg((3 << 11) | 20) & 0xFu; }
DI void grid_barrier(int wv, unsigned* bar_, unsigned k, LAS unsigned* stash) {
    unsigned* bar = (unsigned*)opq((unsigned char*)bar_);
    asm volatile("s_waitcnt vmcnt(0) lgkmcnt(0)" ::: "memory");
    __syncthreads();
    if (mk_tid(wv) == 0) {
        const unsigned xcc = xcc_id(), nx = stash[0], nxcc = stash[1];
        const unsigned old = __hip_atomic_fetch_add(bar + 64 * (17 + xcc), 1u, __ATOMIC_RELAXED, __HIP_MEMORY_SCOPE_AGENT);
        if (old == k * nx - 1u) {
            __builtin_amdgcn_fence(__ATOMIC_RELEASE, "agent");
            asm volatile("s_waitcnt vmcnt(0)" ::: "memory");
            const unsigned old2 = __hip_atomic_fetch_add(bar + 64 * 33, 1u, __ATOMIC_RELAXED, __HIP_MEMORY_SCOPE_AGENT);
            if (old2 == k * nxcc - 1u) __hip_atomic_store(bar + 64 * 34, k, __ATOMIC_RELAXED, __HIP_MEMORY_SCOPE_AGENT);
        }
        while (__hip_atomic_load(bar + 64 * 34, __ATOMIC_RELAXED, __HIP_MEMORY_SCOPE_AGENT) < k) __builtin_amdgcn_s_sleep(2);
        __builtin_amdgcn_fence(__ATOMIC_ACQUIRE, "agent");
        asm volatile("s_waitcnt vmcnt(0)" ::: "memory");
    }
    __syncthreads();
}

__global__ void __launch_bounds__(512) mega(Params p) {
    extern __shared__ __attribute__((aligned(16))) unsigned char shm[];
    LAS unsigned char* lds = (LAS unsigned char*)shm;
    cg::grid_group grid = cg::this_grid();
    const int wv = __builtin_amdgcn_readfirstlane((int)threadIdx.x >> 6);
    int ph = 0; unsigned nbar = 0;
    LAS unsigned* stash = (LAS unsigned*)(lds + LDS_PHASE_BYTES);
#define xb ((bf16_t*)(opq(p.ws) + XB_OFF))
#define wb ((bf16_t*)(opq(p.ws) + WB_OFF))
#define scr (opq(p.ws) + SCR_OFF)
#define barctr ((unsigned*)(opq(p.ws) + BAR_OFF))
#define STT ((float*)(opq(p.ws) + BAR_OFF + 65536))
    float* X = p.out;
    if (mk_tid(wv) == 0) __hip_atomic_fetch_add(barctr + 64 * (1 + xcc_id()), 1u, __ATOMIC_RELAXED, __HIP_MEMORY_SCOPE_AGENT);
#define PH_BEGIN if (ph >= p.ph_lo && ph < p.ph_hi) {
#define PH_END   if (ph + 1 < p.ph_hi) { if (ph == p.ph_lo) { grid.sync(); \
        if (mk_tid(wv) == 0) { unsigned nx_ = __hip_atomic_load(barctr + 64 * (1 + xcc_id()), __ATOMIC_RELAXED, __HIP_MEMORY_SCOPE_AGENT), nxcc_ = 0; \
            for (int x_ = 0; x_ < 16; ++x_) nxcc_ += __hip_atomic_load(barctr + 64 * (1 + x_), __ATOMIC_RELAXED, __HIP_MEMORY_SCOPE_AGENT) != 0u ? 1u : 0u; \
            stash[0] = nx_; stash[1] = nxcc_; } } \
        else { ++nbar; grid_barrier(wv, barctr, nbar, stash); } } } ++ph;
    PH_BEGIN
        xconvert(wv, p.in[0], xb);
        wprep_layer(wv, lds, p, 0, wb);
    PH_END
#pragma nounroll
    for (int layer = 0; layer < 4; ++layer) {
        const int kind = layer % 3, ib = layer_base(layer), wo = wout_idx(layer);
        const int nin = kind == 1 ? 9216 : 3072;
        bf16_t* wb_out = wb + (size_t)nin * 1024; bf16_t* wb_1 = wb_out + 1024 * 1024; bf16_t* wb_2 = wb_1 + 4096 * 1024;
        bf16_t* QK = (bf16_t*)scr;
        bf16_t* VT = (bf16_t*)(scr + (kind == 2 ? 192 : 128) * MiB);
        bf16_t* OB = (bf16_t*)(scr + 192 * MiB);
        float* OACC = (float*)(scr + 256 * MiB); float* STATS = (float*)(scr + 384 * MiB);
        bf16_t* KI = (bf16_t*)(scr + 64 * MiB); float* OBUF = (float*)scr; bf16_t* RB = (bf16_t*)(scr + 128 * MiB);
        bf16_t* QD = (bf16_t*)(scr + 256 * MiB); bf16_t* KST = (bf16_t*)(scr + 288 * MiB); bf16_t* SB = (bf16_t*)(scr + 320 * MiB); float* DEC = (float*)(scr + 336 * MiB);
        bf16_t* H = (bf16_t*)scr;
        const int ng = kind == 1 ? 3 : 1;
#pragma nounroll
        for (int g = 0; g < ng; ++g) {
            const int dil = kind == 1 ? (g == 0 ? 1 : g == 1 ? 4 : 16) : 1;
            PH_BEGIN
                const int ngemm = kind == 2 ? 3 : 2;
#pragma nounroll
                for (int rep = 0; rep < REP_MIXG; ++rep)
#pragma nounroll
                for (int gi = 0; gi < ngemm; ++gi) {
                    GemmD d; EpiBf16<0> E;
                    d.K = 1024; d.dil = 1; d.L = 4096;
                    const bf16_t* wg_ = wb + (size_t)g * 3072 * 1024;
                    const bool isvt = (gi == ngemm - 1);
                    if (!isvt) {
                        d.A = xb; d.lda = 1024; d.ldb = 1024; d.nM = 128;
                        if (kind == 2) { d.Bt = wg_ + (size_t)(gi == 0 ? 0 : 2048) * 1024; d.nN = 4; E.O = gi == 0 ? QK : RB; E.ldc = 1024; }
                        else { d.Bt = wg_; d.nN = 8; E.O = QK; E.ldc = 2048; }
                    } else {
                        d.A = wg_ + (size_t)(kind == 2 ? 1024 : 2048) * 1024; d.lda = 1024; d.nM = 4;
                        d.Bt = xb; d.ldb = 1024; d.nN = 128; d.dil = dil; d.L = 4096 / dil; E.O = VT; E.ldc = M_TOK;
                    }
                    gemm_phase(wv, lds, d, E);
                }
            PH_END
            if (kind == 0) {
                PH_BEGIN
                    for (int rep = 0; rep < REP_DIFF; ++rep) diff_attn_phase(wv, lds, QK, VT, OB, p.in[ib + 1], p.in[ib + 2], p.in[ib + 3], p.in[ib + 4], p.in[ib + 5], layer);
                PH_END
            } else if (kind == 1) {
                PH_BEGIN
                    for (int rep = 0; rep < (g == 0 ? REP_DIL0 : 1); ++rep) { if (rep) __syncthreads(); dil_attn_phase(wv, QK, VT, OACC, STATS, OB, g, dil); }
                PH_END
            } else {
                PH_BEGIN
                    for (int rep = 0; rep < REP_GATE; ++rep) { if (rep) __syncthreads(); gla_gate_phase(wv, lds, X, p.in[ib], p.in[ib + 1], p.in[ib + 2], QK, QD, KI, KST, DEC, SB); }
                PH_END
                PH_BEGIN
                    for (int rep = 0; rep < REP_SCAN; ++rep) gla_scan_phase(wv, lds, QD, KST, SB, VT, DEC, OBUF);
                PH_END
                PH_BEGIN
                    gla_finish_phase(wv, OBUF, RB, p.in[ib + 3], OB);
                PH_END
            }
        }
#pragma nounroll
        for (int sub = 0; sub < 2; ++sub) {
            if (sub == 1) {
                PH_BEGIN
                    GemmD d; EpiBf16<1> E;
                    d.A = xb; d.lda = 1024; d.Bt = wb_1; d.ldb = 1024; d.K = 1024; d.nM = 128; d.nN = 16; d.dil = 1; d.L = 4096; E.O = H; E.ldc = 4096;
#pragma nounroll
                    for (int rep = 0; rep < REP_FFN1; ++rep) gemm_phase(wv, lds, d, E);
                PH_END
            }
            PH_BEGIN
                GemmD d; EpiRes E;
                d.A = sub == 0 ? OB : H; d.lda = sub == 0 ? 1024 : 4096; d.Bt = sub == 0 ? wb_out : wb_2; d.ldb = d.lda; d.K = d.lda; d.nM = 128; d.nN = 4; d.dil = 1; d.L = 4096;
                E.res = xb; E.out = (bf16_t*)(scr + 256 * MiB);
                gemm_phase(wv, lds, d, E);
            PH_END
            PH_BEGIN
                ln_phase(wv, (const bf16_t*)(scr + 256 * MiB), ((layer == 3 || layer == 1) && sub == 1) ? X : nullptr, p.in[wo + 1 + 4 * sub], p.in[wo + 2 + 4 * sub], xb);
                if (sub == 1 && layer < 3) for (int rep = 0; rep < REP_PREP; ++rep) { if (rep) __syncthreads(); wprep_layer(wv, lds, p, layer + 1, wb); }
            PH_END
        }
    }
}

#undef xb
#undef wb
#undef scr
#undef barctr
#undef STT
extern "C" void kernel_launch(void* const* d_in, const int* in_sizes, int n_in, void* d_out, int out_size, void* d_ws, size_t ws_size, hipStream_t stream) {
    static int grid = 0;
    if (grid == 0) {
        if (n_in != 46 || ws_size < WS_NEED) { fprintf(stderr, "kernel_launch: unexpected n_in %d or ws_size %zu\n", n_in, ws_size); grid = -1; return; }
        int dev = 0, cus = 0, per_cu = 0;
        hipGetDevice(&dev);
        hipDeviceGetAttribute(&cus, hipDeviceAttributeMultiprocessorCount, dev);
        hipFuncSetAttribute((const void*)mega, hipFuncAttributeMaxDynamicSharedMemorySize, LDS_BYTES);
        hipOccupancyMaxActiveBlocksPerMultiprocessor(&per_cu, (const void*)mega, 512, LDS_BYTES);
        if (per_cu < 1) { fprintf(stderr, "kernel_launch: occupancy query says %d blocks per CU\n", per_cu); per_cu = 1; }
        (void)hipGetLastError();
        grid = cus * per_cu;
    }
    if (grid < 0) return;
    Params p{};
    for (int i = 0; i < 46; ++i) p.in[i] = (const float*)d_in[i];
    p.out = (float*)d_out; p.ws = (unsigned char*)d_ws;
#if MULTI_LAUNCH
    for (int ph = 0; ph < NPH; ++ph) { p.ph_lo = ph; p.ph_hi = ph + 1; hipLaunchKernelGGL(mega, dim3(grid), dim3(512), LDS_BYTES, stream, p); }
#else
    p.ph_lo = 0; p.ph_hi = NPH;
    (void)hipMemsetAsync((unsigned char*)d_ws + BAR_OFF, 0, 16384, stream);
    void* args[] = {&p};
    hipError_t e = hipLaunchCooperativeKernel((const void*)mega, dim3(grid), dim3(512), args, LDS_BYTES, stream);
    if (e != hipSuccess) fprintf(stderr, "cooperative launch failed: %s (grid %d)\n", hipGetErrorString(e), grid);
#endif
}
```

```cpp
#include <hip/hip_runtime.h>
#include <hip/hip_cooperative_groups.h>
#include <cstdio>
namespace cg = cooperative_groups;

#ifndef MULTI_LAUNCH
#define MULTI_LAUNCH 0
#endif

#define REP_MIXG 1
#define REP_FFN1 1
#define REP_DIL0 1
#define REP_GATE 1
#define REP_SCAN 1
#define REP_DIFF 1
#define REP_PREP 1
#define DI __device__ __forceinline__
#define LAS __attribute__((address_space(3)))
typedef unsigned short bf16_t;
typedef short bf16x8 __attribute__((ext_vector_type(8)));
typedef short s16x4 __attribute__((ext_vector_type(4)));
typedef float f32x2 __attribute__((ext_vector_type(2)));
typedef float f32x4 __attribute__((ext_vector_type(4)));
typedef float f32x16 __attribute__((ext_vector_type(16)));
typedef unsigned u32x2 __attribute__((ext_vector_type(2)));
typedef unsigned u32x4 __attribute__((ext_vector_type(4)));
typedef __bf16 bf2_t __attribute__((ext_vector_type(2)));

constexpr int M_TOK = 32768, DM = 1024, SEQ = 4096, NPH = 35;
constexpr float LOG2E = 1.4426950408889634f;
constexpr float ALPHA_RES = 1.681792830507429f;
constexpr size_t MiB = 1024 * 1024;
constexpr size_t XB_OFF = 0, WB_OFF = 64 * MiB, SCR_OFF = 104 * MiB, BAR_OFF = 491 * MiB, WS_NEED = 492 * MiB;
constexpr int LDS_PHASE_BYTES = 131072, LDS_BYTES = LDS_PHASE_BYTES + 256;

struct Params {
    const float* in[46];
    float* out;
    unsigned char* ws;
    int ph_lo, ph_hi;
};

DI unsigned pk2(float lo, float hi) { f32x2 f = {lo, hi}; bf2_t v = __builtin_convertvector(f, bf2_t); return __builtin_bit_cast(unsigned, v); }
DI bf16_t f2bf(float x) { return (bf16_t)(pk2(x, 0.f) & 0xffffu); }
DI float bf2f(bf16_t v) { return __uint_as_float(((unsigned)v) << 16); }
DI float wave_sum(float v) {
#pragma unroll
    for (int o = 1; o < 64; o <<= 1) v += __shfl_xor(v, o);
    return v;
}
DI int mk_tid(int wv) { int w = wv; asm volatile("" : "+s"(w)); int l = __builtin_amdgcn_mbcnt_hi(~0u, __builtin_amdgcn_mbcnt_lo(~0u, 0u)); asm volatile("" : "+v"(l)); return w * 64 + l; }
DI unsigned char* opq(unsigned char* p) { asm volatile("" : "+s"(p)); return p; }
DI int opaque_bid() { int b = blockIdx.x; asm volatile("" : "+s"(b)); return b; }
DI float fexp2(float x) { return __builtin_amdgcn_exp2f(x); }
DI int crow(int i, int hh) { return (i & 3) + 8 * (i >> 2) + 4 * hh; }
#define MFMA32(a, b, c) __builtin_amdgcn_mfma_f32_32x32x16_bf16((a), (b), (c), 0, 0, 0)
DI bf16x8 cat44(s16x4 lo, s16x4 hi) { return __builtin_shufflevector(lo, hi, 0, 1, 2, 3, 4, 5, 6, 7); }
DI bf16x8 pack8(const f32x16& x, int s) {
    u32x4 w;
    w.x = pk2(x[8 * s + 0], x[8 * s + 1]); w.y = pk2(x[8 * s + 2], x[8 * s + 3]);
    w.z = pk2(x[8 * s + 4], x[8 * s + 5]); w.w = pk2(x[8 * s + 6], x[8 * s + 7]);
    return __builtin_bit_cast(bf16x8, w);
}
DI f32x16 zero16() { f32x16 z; for (int i = 0; i < 16; ++i) z[i] = 0.f; return z; }

constexpr int BM = 256, BK = 64, HALF = 128, HTB = HALF * BK * 2, NXCD = 8, WGM = 8;
DI int lds_byte(int r, int c) { const int st = (r >> 4) * 2 + (c >> 5), rr = r & 15, cc = c & 31, ob = rr * 64 + cc * 2; return st * 1024 + (ob ^ (((ob >> 9) & 1) << 5)); }
DI void stage_rc(int b, int& R, int& C) { const int st = b / 1024, sb = b % 1024, swz = sb ^ (((sb >> 9) & 1) << 5); R = (st >> 1) * 16 + swz / 64; C = (st & 1) * 32 + (swz % 64) / 2; }
DI int perm32(int rho) { const int n = rho >> 4, i = rho & 15; return 8 * (i >> 2) + 4 * n + (i & 3); }

struct Unit { int pm, pn; };
struct GemmD { const bf16_t* A; const bf16_t* Bt; int lda, ldb, K, nM, nN, dil, L; };
struct StaticOrder {
    int nM, nN, nwg, G, c;
    DI void init(int nM_, int nN_, int G_, int c_) { nM = nM_; nN = nN_; nwg = nM * nN; G = G_; c = c_; }
    DI bool next(int i, Unit& u) const {
        const long Lx = (long)i * G + c; if (Lx >= nwg) return false;
        int wgid = (int)Lx; { const int q = nwg / NXCD, r = nwg % NXCD, xcd = wgid % NXCD, off = wgid / NXCD; wgid = (xcd < r ? xcd * (q + 1) : r * (q + 1) + (xcd - r) * q) + off; }
        const int nig = WGM * nN, gid = wgid / nig, fm = gid * WGM, gsz = (nM - fm) < WGM ? (nM - fm) : WGM;
        u.pm = fm + ((wgid % nig) % gsz); u.pn = (wgid % nig) / gsz; return true;
    }
};

template <int ACT  > struct EpiBf16 {
    static constexpr bool PERM = true;
    bf16_t* O; size_t ldc;
    DI void operator()(const f32x4 (&acc)[2][2][4][2], const Unit& u, int wr, int wc, int fr, int fq) const {
        const int row0 = u.pm * BM + wr * 64 + fr; const int col0 = u.pn * BM + wc * 32 + 8 * fq;
#pragma unroll
        for (int ai = 0; ai < 2; ++ai)
#pragma unroll
            for (int m = 0; m < 4; ++m) { bf16_t* rowp = O + (size_t)(row0 + ai * HALF + m * 16) * ldc + col0;
#pragma unroll
                for (int bj = 0; bj < 2; ++bj) { f32x4 v0 = acc[ai][bj][m][0], v1 = acc[ai][bj][m][1];
                    if (ACT == 1) {
#pragma unroll
                        for (int j = 0; j < 4; ++j) { float a = fmaxf(v0[j], 0.f), b = fmaxf(v1[j], 0.f); v0[j] = a * a; v1[j] = b * b; } }
                    u32x4 w; w.x = pk2(v0[0], v0[1]); w.y = pk2(v0[2], v0[3]); w.z = pk2(v1[0], v1[1]); w.w = pk2(v1[2], v1[3]);
                    *(u32x4*)(rowp + bj * HALF) = w; } }
    }
};
struct EpiRes {
    static constexpr bool PERM = true;
    const bf16_t* res; bf16_t* out;
    DI void operator()(const f32x4 (&acc)[2][2][4][2], const Unit& u, int wr, int wc, int fr, int fq) const {
        const int row0 = u.pm * BM + wr * 64 + fr, col0 = u.pn * BM + wc * 32 + 8 * fq;
#pragma unroll
        for (int ai = 0; ai < 2; ++ai)
#pragma unroll
            for (int m = 0; m < 4; ++m) { const size_t ro = (size_t)(row0 + ai * HALF + m * 16) * DM + col0;
#pragma unroll
                for (int bj = 0; bj < 2; ++bj) { const u32x4 r = *(const u32x4*)(res + ro + bj * HALF);
                    const f32x4 v0 = acc[ai][bj][m][0], v1 = acc[ai][bj][m][1];
                    u32x4 w;
                    w.x = pk2(__uint_as_float(r.x << 16) * ALPHA_RES + v0[0], __uint_as_float(r.x & 0xffff0000u) * ALPHA_RES + v0[1]);
                    w.y = pk2(__uint_as_float(r.y << 16) * ALPHA_RES + v0[2], __uint_as_float(r.y & 0xffff0000u) * ALPHA_RES + v0[3]);
                    w.z = pk2(__uint_as_float(r.z << 16) * ALPHA_RES + v1[0], __uint_as_float(r.z & 0xffff0000u) * ALPHA_RES + v1[1]);
                    w.w = pk2(__uint_as_float(r.w << 16) * ALPHA_RES + v1[2], __uint_as_float(r.w & 0xffff0000u) * ALPHA_RES + v1[3]);
                    *(u32x4*)(out + ro + bj * HALF) = w; } }
    }
};

template <class Epi>
DI void gemm_phase(int wv, LAS unsigned char* lds, const GemmD g, const Epi& E) {
    const int tid = mk_tid(wv), wid = __builtin_amdgcn_readfirstlane(tid >> 6), lane = tid & 63, wr = wid >> 2, wc = wid & 3, fr = lane & 15, fq = lane >> 4;
    const int K = g.K, nt = K / BK;
    const int ldbe = g.ldb * g.dil;
    unsigned voffA[2], voffB[2];
#pragma unroll
    for (int i = 0; i < 2; ++i) { int R, C; stage_rc(tid * 16 + i * 8192, R, C); const int Rb = Epi::PERM ? ((R & ~31) + perm32(R & 31)) : R;
        voffA[i] = (unsigned)(R * g.lda + C) * 2u; voffB[i] = (unsigned)(Rb * ldbe + C) * 2u; }
    const size_t kstep = (size_t)(BK * 2);
    const size_t hstepA = (size_t)HALF * g.lda * 2, hstepB = (size_t)HALF * ldbe * 2;
    const unsigned ldsw = (unsigned)wid * 1024u;
    const int aoff = lds_byte(wr * 64 + fr, fq * 8), boff = lds_byte(wc * 32 + fr, fq * 8);
#define PG8_SA(b, h) (((b) * 2 + (h)) * HTB)
#define PG8_SB(b, h) ((4 + (b) * 2 + (h)) * HTB)
#define PG8_STAGE(bufoff, gbase, voff) do { _Pragma("unroll") for (int _i = 0; _i < 2; ++_i) \
        __builtin_amdgcn_global_load_lds((const unsigned*)((const char*)(gbase) + (voff)[_i]), (LAS unsigned*)(lds + (bufoff) + ldsw + _i * 8192), 16, 0, 0); } while (0)
#define PG8_LDA(dst, b, h) do { _Pragma("unroll") for (int m = 0; m < 4; ++m) _Pragma("unroll") for (int k = 0; k < 2; ++k) dst[m][k] = *(const LAS bf16x8*)(lds + PG8_SA(b, h) + aoff + m * 2048 + k * 1024); } while (0)
#define PG8_LDB(dst, b, h) do { _Pragma("unroll") for (int n = 0; n < 2; ++n) _Pragma("unroll") for (int k = 0; k < 2; ++k) dst[n][k] = *(const LAS bf16x8*)(lds + PG8_SB(b, h) + boff + n * 2048 + k * 1024); } while (0)
#define PG8_MMA(ai, bj, At, Bt) do { __builtin_amdgcn_s_setprio(1); _Pragma("unroll") for (int m = 0; m < 4; ++m) _Pragma("unroll") for (int n = 0; n < 2; ++n) _Pragma("unroll") for (int k = 0; k < 2; ++k) \
        acc[ai][bj][m][n] = __builtin_amdgcn_mfma_f32_16x16x32_bf16(Bt[n][k], At[m][k], acc[ai][bj][m][n], 0, 0, 0); __builtin_amdgcn_s_setprio(0); } while (0)
#define PG8_WAIT_V(n) asm volatile("s_waitcnt vmcnt(" #n ")" ::: "memory")
#define PG8_WAIT_L(n) asm volatile("s_waitcnt lgkmcnt(" #n ")" ::: "memory")
#define PG8_BAR __builtin_amdgcn_s_barrier()
#define PG8_SCHED __builtin_amdgcn_sched_barrier(0)
    StaticOrder S; S.init(g.nM, g.nN, (int)gridDim.x, opaque_bid());
    Unit cur, nxt; int ui = 0;
    if (!S.next(0, cur)) return;
    f32x4 acc[2][2][4][2];
#pragma unroll
    for (int a = 0; a < 2; ++a)
#pragma unroll
        for (int b = 0; b < 2; ++b)
#pragma unroll
            for (int m = 0; m < 4; ++m)
#pragma unroll
                for (int n = 0; n < 2; ++n) acc[a][b][m][n] = (f32x4){0.f, 0.f, 0.f, 0.f};
    bf16x8 At[4][2], B0[2][2], B1[2][2];
#define PG8_BROW(pn_) ({ const int p0_ = (pn_) * 256; const int bb_ = p0_ >> 12, rem_ = p0_ & 4095, r_ = rem_ / g.L, l0_ = rem_ - r_ * g.L; (size_t)(bb_ * 4096 + l0_ * g.dil + r_); })
    const char* cA = (const char*)g.A + (size_t)cur.pm * 256 * g.lda * 2; const char* cB = (const char*)g.Bt + PG8_BROW(cur.pn) * (size_t)g.ldb * 2;
    PG8_STAGE(PG8_SB(0, 0), cB, voffB); PG8_STAGE(PG8_SA(0, 0), cA, voffA); PG8_STAGE(PG8_SB(0, 1), cB + hstepB, voffB); PG8_STAGE(PG8_SA(0, 1), cA + hstepA, voffA);
    if (wr == 1) PG8_BAR;
    PG8_WAIT_V(4); PG8_BAR;
    PG8_STAGE(PG8_SB(1, 0), cB + kstep, voffB); PG8_STAGE(PG8_SA(1, 0), cA + kstep, voffA); PG8_STAGE(PG8_SB(1, 1), cB + hstepB + kstep, voffB);
    PG8_WAIT_V(6); PG8_BAR;
    for (;;) {
        const bool has_next = S.next(ui + 1, nxt);
        const char* nA = has_next ? (const char*)g.A + (size_t)nxt.pm * 256 * g.lda * 2 : cA; const char* nB = has_next ? (const char*)g.Bt + PG8_BROW(nxt.pn) * (size_t)g.ldb * 2 : cB;
        for (int t = 0; t < nt; t += 2) {
            const bool last = (t == nt - 2);
            const char* a1 = cA + (size_t)(t + 1) * kstep;
            const char* a2 = last ? nA : cA + (size_t)(t + 2) * kstep; const char* b2 = last ? nB : cB + (size_t)(t + 2) * kstep;
            const char* a3 = a2 + kstep; const char* b3 = b2 + kstep;
            PG8_LDB(B0, 0, 0); PG8_SCHED; PG8_LDA(At, 0, 0); PG8_STAGE(PG8_SA(1, 1), a1 + hstepA, voffA);
            PG8_WAIT_L(8); PG8_BAR; PG8_WAIT_L(0); PG8_MMA(0, 0, At, B0); PG8_BAR; PG8_SCHED;
            PG8_LDB(B1, 0, 1); PG8_STAGE(PG8_SB(0, 0), b2, voffB);
            PG8_BAR; PG8_WAIT_L(0); PG8_MMA(0, 1, At, B1); PG8_BAR;
            PG8_LDA(At, 0, 1); PG8_STAGE(PG8_SA(0, 0), a2, voffA);
            PG8_BAR; PG8_WAIT_L(0); PG8_MMA(1, 0, At, B0); PG8_BAR; PG8_SCHED;
            PG8_STAGE(PG8_SB(0, 1), b2 + hstepB, voffB);
            PG8_WAIT_V(6); PG8_BAR; PG8_MMA(1, 1, At, B1); PG8_BAR;
            PG8_LDB(B0, 1, 0); PG8_SCHED; PG8_LDA(At, 1, 0); PG8_STAGE(PG8_SA(0, 1), a2 + hstepA, voffA);
            PG8_WAIT_L(8); PG8_BAR; PG8_WAIT_L(0); PG8_MMA(0, 0, At, B0); PG8_BAR; PG8_SCHED;
            PG8_LDB(B1, 1, 1); PG8_STAGE(PG8_SB(1, 0), b3, voffB);
            PG8_BAR; PG8_WAIT_L(0); PG8_MMA(0, 1, At, B1); PG8_BAR;
            PG8_LDA(At, 1, 1); PG8_STAGE(PG8_SA(1, 0), a3, voffA);
            PG8_BAR; PG8_WAIT_L(0); PG8_MMA(1, 0, At, B0); PG8_BAR; PG8_SCHED;
            PG8_STAGE(PG8_SB(1, 1), b3 + hstepB, voffB);
            PG8_WAIT_V(6); PG8_BAR; PG8_MMA(1, 1, At, B1); PG8_BAR;
        }
        E(acc, cur, wr, wc, fr, fq);
        if (!has_next) break;
#pragma unroll
        for (int a = 0; a < 2; ++a)
#pragma unroll
            for (int b = 0; b < 2; ++b)
#pragma unroll
                for (int m = 0; m < 4; ++m)
#pragma unroll
                    for (int n = 0; n < 2; ++n) acc[a][b][m][n] = (f32x4){0.f, 0.f, 0.f, 0.f};
        cur = nxt; cA = nA; cB = nB; ++ui;
    }
    PG8_WAIT_V(0);
    if (wr == 0) PG8_BAR;
    PG8_BAR;
#undef PG8_BROW
#undef PG8_SA
#undef PG8_SB
#undef PG8_STAGE
#undef PG8_LDA
#undef PG8_LDB
#undef PG8_MMA
#undef PG8_WAIT_V
#undef PG8_WAIT_L
#undef PG8_BAR
#undef PG8_SCHED
}

DI void transpose_item(const float* W, int K, int ldw, int nblk, bf16_t* WT, LAS float* scr, int item, int lane) {
    const int kb = item / nblk, nb = item % nblk, k0 = 64 * kb, n0 = 32 * nb;
    float wv_[32];
#pragma unroll
    for (int i = 0; i < 32; ++i) { const int kk = 2 * i + (lane >> 5); wv_[i] = W[(size_t)(k0 + kk) * ldw + n0 + (lane & 31)]; }
#pragma unroll
    for (int i = 0; i < 32; ++i) { const int kk = 2 * i + (lane >> 5); scr[kk * 33 + (lane & 31)] = wv_[i]; }
    asm volatile("s_waitcnt lgkmcnt(0)" ::: "memory");
    const int c = lane & 7;
#pragma unroll
    for (int j = 0; j < 4; ++j) { const int n = (lane >> 3) + 8 * j; const LAS float* s = scr + (8 * c) * 33 + n;
        u32x4 o; o.x = pk2(s[0 * 33], s[1 * 33]); o.y = pk2(s[2 * 33], s[3 * 33]); o.z = pk2(s[4 * 33], s[5 * 33]); o.w = pk2(s[6 * 33], s[7 * 33]);
        *(u32x4*)(WT + (size_t)(n0 + n) * K + k0 + 8 * c) = o; }
    asm volatile("s_waitcnt lgkmcnt(0)" ::: "memory");
}
DI int layer_base(int layer) { return layer == 0 ? 1 : layer == 1 ? 14 : layer == 2 ? 22 : 33; }
DI int wout_idx(int layer) { const int kind = layer % 3; return layer_base(layer) + (kind == 0 ? 6 : kind == 1 ? 1 : 4); }
DI void wprep_layer(int wv, LAS unsigned char* lds, const Params& p, int layer, bf16_t* wb) {
    const int kind = layer % 3, nin = kind == 1 ? 9216 : 3072, ldw_in = kind == 1 ? 9216 : kind == 2 ? 3088 : 3072;
    const int wo = wout_idx(layer);
    const float* w_in = p.in[layer_base(layer)]; const float* w_out = p.in[wo]; const float* w1 = p.in[wo + 3]; const float* w2 = p.in[wo + 4];
    bf16_t* wb_out = wb + (size_t)nin * 1024; bf16_t* wb_1 = wb_out + 1024 * 1024; bf16_t* wb_2 = wb_1 + 4096 * 1024;
    const int tid = mk_tid(wv), wid = tid >> 6, lane = tid & 63; const int bid = opaque_bid();
    LAS float* scr = (LAS float*)(lds + wid * 8448);
    const int I0 = 16 * (nin / 32), I1 = 16 * 32, I2 = 16 * 128, I3 = 64 * 32, tot = I0 + I1 + I2 + I3;
    for (int it = bid * 8 + wid; it < tot; it += gridDim.x * 8) {
        int r = it;
        if (r < I0) { transpose_item(w_in, 1024, ldw_in, nin / 32, wb, scr, r, lane); continue; } r -= I0;
        if (r < I1) { transpose_item(w_out, 1024, 1024, 32, wb_out, scr, r, lane); continue; } r -= I1;
        if (r < I2) { transpose_item(w1, 1024, 4096, 128, wb_1, scr, r, lane); continue; } r -= I2;
        transpose_item(w2, 4096, 1024, 32, wb_2, scr, r, lane);
    }
}
DI void xconvert(int wv, const float* x, bf16_t* xb) {
    const size_t n8 = (size_t)M_TOK * DM / 8;
    const size_t st_ = (size_t)gridDim.x * 512;
    for (size_t i = (size_t)opaque_bid() * 512 + mk_tid(wv); i < n8; i += 4 * st_) {
        f32x4 a[4], b[4];
#pragma unroll
        for (int u = 0; u < 4; ++u) { const size_t j = (i + u * st_ < n8) ? i + u * st_ : i; a[u] = ((const f32x4*)x)[2 * j]; b[u] = ((const f32x4*)x)[2 * j + 1]; }
#pragma unroll
        for (int u = 0; u < 4; ++u) if (i + u * st_ < n8) { u32x4 w; w.x = pk2(a[u].x, a[u].y); w.y = pk2(a[u].z, a[u].w); w.z = pk2(b[u].x, b[u].y); w.w = pk2(b[u].z, b[u].w);
            ((u32x4*)xb)[i + u * st_] = w; }
    }
}
DI void ln_phase(int wv, const bf16_t* y, float* xo, const float* g, const float* bta, bf16_t* xb) {
    const int tid = mk_tid(wv), wid = tid >> 6, lane = tid & 63; const int bid = opaque_bid();
    f32x4 gv[4], bv[4];
#pragma unroll
    for (int j = 0; j < 2; ++j) { gv[2 * j] = *(const f32x4*)(g + j * 512 + lane * 8); gv[2 * j + 1] = *(const f32x4*)(g + j * 512 + lane * 8 + 4);
                                  bv[2 * j] = *(const f32x4*)(bta + j * 512 + lane * 8); bv[2 * j + 1] = *(const f32x4*)(bta + j * 512 + lane * 8 + 4); }
    const int nw = gridDim.x * 8;
    constexpr int R = 4;
    for (int row0 = bid * 8 + wid; row0 < M_TOK; row0 += R * nw) {
        u32x4 raw[R][2], rsd[R][2];
#pragma unroll
        for (int r = 0; r < R; ++r) { const int row = (row0 + r * nw < M_TOK) ? row0 + r * nw : row0;
#pragma unroll
            for (int j = 0; j < 2; ++j) { raw[r][j] = *(const u32x4*)(y + (size_t)row * DM + j * 512 + lane * 8); rsd[r][j] = *(const u32x4*)(xb + (size_t)row * DM + j * 512 + lane * 8); } }
#pragma unroll
        for (int r = 0; r < R; ++r) {
            const int row = row0 + r * nw;
            if (row < M_TOK) {
                f32x4 v[4];
#pragma unroll
                for (int j = 0; j < 2; ++j) { const u32x4 q = raw[r][j], x_ = rsd[r][j];
                    v[2 * j] = (f32x4){__uint_as_float(q.x << 16), __uint_as_float(q.x & 0xffff0000u), __uint_as_float(q.y << 16), __uint_as_float(q.y & 0xffff0000u)}
                             + (f32x4){__uint_as_float(x_.x << 16), __uint_as_float(x_.x & 0xffff0000u), __uint_as_float(x_.y << 16), __uint_as_float(x_.y & 0xffff0000u)} * ALPHA_RES;
                    v[2 * j + 1] = (f32x4){__uint_as_float(q.z << 16), __uint_as_float(q.z & 0xffff0000u), __uint_as_float(q.w << 16), __uint_as_float(q.w & 0xffff0000u)}
                                 + (f32x4){__uint_as_float(x_.z << 16), __uint_as_float(x_.z & 0xffff0000u), __uint_as_float(x_.w << 16), __uint_as_float(x_.w & 0xffff0000u)} * ALPHA_RES; }
                float s_ = 0.f;
#pragma unroll
                for (int j = 0; j < 4; ++j) s_ += (v[j].x + v[j].y) + (v[j].z + v[j].w);
                const float mean = wave_sum(s_) * (1.f / DM); float s2 = 0.f;
#pragma unroll
                for (int j = 0; j < 4; ++j) { v[j] = v[j] - mean; s2 += (v[j].x * v[j].x + v[j].y * v[j].y) + (v[j].z * v[j].z + v[j].w * v[j].w); }
                const float rstd = 1.f / sqrtf(wave_sum(s2) * (1.f / DM) + 1e-5f);
#pragma unroll
                for (int j = 0; j < 2; ++j) { const f32x4 y0 = v[2 * j] * rstd * gv[2 * j] + bv[2 * j], y1 = v[2 * j + 1] * rstd * gv[2 * j + 1] + bv[2 * j + 1];
                    if (xo) { *(f32x4*)(xo + (size_t)row * DM + j * 512 + lane * 8) = y0; *(f32x4*)(xo + (size_t)row * DM + j * 512 + lane * 8 + 4) = y1; }
                    u32x4 w; w.x = pk2(y0.x, y0.y); w.y = pk2(y0.z, y0.w); w.z = pk2(y1.x, y1.y); w.w = pk2(y1.z, y1.w);
                    *(u32x4*)(xb + (size_t)row * DM + j * 512 + lane * 8) = w; }
            }
        }
    }
}

constexpr int DA_KP = 272, DA_VP = 144, DA_KB = 64 * DA_KP, DA_BUF = DA_KB + 128 * DA_VP;
DI void diff_attn_phase(int wv, LAS unsigned char* lds, const bf16_t* qk, const bf16_t* vt, bf16_t* ob, const float* lq1, const float* lk1, const float* lq2, const float* lk2,
                        const float* subg, int layer_idx) {
    const int tid = mk_tid(wv), wid = __builtin_amdgcn_readfirstlane(tid >> 6), lane = tid & 63, rr = lane & 31, hh = lane >> 5; const int bid = opaque_bid();
    const int map = wid >> 2, qsub = wid & 3;
    int li_ = layer_idx; asm volatile("" : "+s"(li_)); const float lambda_init = (li_ == 0) ? 0.2f : 0.5560582041f;
    const float d1 = wave_sum(lq1[lane] * lk1[lane]), d2 = wave_sum(lq2[lane] * lk2[lane]);
    const float lam = expf(d1) - expf(d2) + lambda_init;
    LAS float* xch = (LAS float*)lds;
    const float c1 = 0.125f * LOG2E;
    const int prr = (rr & 0x13) | ((rr & 4) << 1) | ((rr & 8) >> 1);
    const int koff = prr * DA_KP + (map * 64 + hh * 8) * 2;
    const int voff = DA_KB + rr * DA_VP + hh * 16;
    const int krow0 = tid >> 4, kch = tid & 15, vrow0 = tid >> 3, vch = tid & 7;
    const int kst_off = krow0 * DA_KP + kch * 16, vst_off = DA_KB + vrow0 * DA_VP + vch * 16;
    for (int it = bid; it < 2048; it += gridDim.x) {
        const int rho = it >> 8, j = it & 255, grp = j >> 6, bh = j & 63;
        const int qb = 28 - 4 * rho + ((rho & 1) ? grp : 3 - grp);
        const int b = bh >> 3, hd = bh & 7;
        const int q0 = qb * 128 + qsub * 32, nkt = 2 * qb + 2, qpos = q0 + rr;
        const float slope2 = exp2f(-(float)(hd + 1)) * LOG2E;
        const bf16_t* qkb = qk + (size_t)b * SEQ * 2048;
        bf16x8 qf[4];
#pragma unroll
        for (int ks = 0; ks < 4; ++ks) qf[ks] = *(const bf16x8*)(qkb + (size_t)(q0 + rr) * 2048 + hd * 128 + map * 64 + ks * 16 + hh * 8);
        const bf16_t* kg = qkb + 1024 + hd * 128 + kch * 8 + (size_t)krow0 * 2048;
        const bf16_t* vg = vt + (size_t)(hd * 128 + vrow0) * M_TOK + (size_t)b * SEQ + vch * 8;
        float cb[16];
#pragma unroll
        for (int i = 0; i < 16; ++i) cb[i] = slope2 * (float)((i & 7) + 16 * (i >> 3));
        f32x16 O[4];
#pragma unroll
        for (int d = 0; d < 4; ++d) O[d] = zero16();
        float m = -INFINITY, l = 0.f;
        u32x4 gk[2], gv[2];
#pragma unroll
        for (int i = 0; i < 2; ++i) { gk[i] = *(const u32x4*)(kg + (size_t)i * 32 * 2048); gv[i] = *(const u32x4*)(vg + (size_t)i * 64 * M_TOK); }
#pragma unroll
        for (int i = 0; i < 2; ++i) { *(LAS u32x4*)(lds + kst_off + i * 32 * DA_KP) = gk[i]; *(LAS u32x4*)(lds + vst_off + i * 64 * DA_VP) = gv[i]; }
        __syncthreads();
        for (int t = 0; t < nkt; ++t) {
            const int key0 = t * 64;
            const bool more = (t + 1 < nkt);
            if (more) {
#pragma unroll
                for (int i = 0; i < 2; ++i) { gk[i] = *(const u32x4*)(kg + (size_t)(key0 + 64 + i * 32) * 2048); gv[i] = *(const u32x4*)(vg + (size_t)i * 64 * M_TOK + key0 + 64); } }
            LAS unsigned char* buf = lds + (t & 1) * DA_BUF;
            if (key0 <= q0 + 31) {
                f32x16 S0 = zero16(), S1 = zero16();
                {
                    bf16x8 kf[2][4];
#pragma unroll
                    for (int sub = 0; sub < 2; ++sub)
#pragma unroll
                        for (int ks = 0; ks < 4; ++ks) kf[sub][ks] = *(const LAS bf16x8*)(buf + koff + sub * 32 * DA_KP + ks * 32);
#pragma unroll
                    for (int ks = 0; ks < 4; ++ks) { S0 = MFMA32(kf[0][ks], qf[ks], S0); S1 = MFMA32(kf[1][ks], qf[ks], S1); }
                }
                __builtin_amdgcn_sched_barrier(0);
                bf16x8 vf[4][2];
#pragma unroll
                for (int d = 0; d < 4; ++d)
#pragma unroll
                    for (int s2 = 0; s2 < 2; ++s2) vf[d][s2] = *(const LAS bf16x8*)(buf + voff + d * 32 * DA_VP + (16 * s2) * 2);
                const float base = slope2 * (float)(key0 + 8 * hh - qpos), b32 = 32.f * slope2;
#pragma unroll
                for (int i = 0; i < 16; ++i) { S0[i] = S0[i] * c1 + cb[i]; S1[i] = S1[i] * c1 + cb[i]; }
                if (key0 + 63 > q0) {
                    const int kq = qpos - key0 - 8 * hh;
#pragma unroll
                    for (int i = 0; i < 16; ++i) { const int ko = (i & 7) + 16 * (i >> 3); S0[i] = (ko > kq) ? -INFINITY : S0[i]; S1[i] = (ko + 32 > kq) ? -INFINITY : S1[i]; }
                }
                float mx = -INFINITY, mx1 = -INFINITY;
#pragma unroll
                for (int i = 0; i < 16; ++i) { mx = fmaxf(mx, S0[i]); mx1 = fmaxf(mx1, S1[i]); }
                mx = fmaxf(mx, mx1 + b32) + base;
                mx = fmaxf(mx, __shfl_xor(mx, 32));
                {
                    const float mn = fmaxf(m, mx), alpha = fexp2(m - mn); m = mn; l *= alpha;
#pragma unroll
                    for (int d = 0; d < 4; ++d) O[d] = O[d] * alpha;
                }
                const float off = base - m, off1 = off + b32;
                float ps = 0.f;
#pragma unroll
                for (int i = 0; i < 16; ++i) { S0[i] = fexp2(S0[i] + off); S1[i] = fexp2(S1[i] + off1); ps += S0[i] + S1[i]; }
                l += ps;
                const bf16x8 p0 = pack8(S0, 0), p1 = pack8(S0, 1), p2 = pack8(S1, 0), p3 = pack8(S1, 1);
                __builtin_amdgcn_sched_barrier(0);
#pragma unroll
                for (int d = 0; d < 4; ++d) { O[d] = MFMA32(vf[d][0], p0, O[d]); O[d] = MFMA32(vf[d][1], p1, O[d]); }
                __builtin_amdgcn_sched_barrier(0);
#pragma unroll
                for (int d = 0; d < 4; ++d)
#pragma unroll
                    for (int s2 = 0; s2 < 2; ++s2) vf[d][s2] = *(const LAS bf16x8*)(buf + voff + d * 32 * DA_VP + (32 + 16 * s2) * 2);
#pragma unroll
                for (int d = 0; d < 4; ++d) { O[d] = MFMA32(vf[d][0], p2, O[d]); O[d] = MFMA32(vf[d][1], p3, O[d]); }
            }
            if (more) {
                LAS unsigned char* nb = lds + ((t + 1) & 1) * DA_BUF;
#pragma unroll
                for (int i = 0; i < 2; ++i) { *(LAS u32x4*)(nb + kst_off + i * 32 * DA_KP) = gk[i]; *(LAS u32x4*)(nb + vst_off + i * 64 * DA_VP) = gv[i]; } }
            __syncthreads();
        }
        const float lt = l + __shfl_xor(l, 32), inv = 1.f / lt;
        if (map == 1) { const float f = lam * inv;
#pragma unroll
            for (int d = 0; d < 4; ++d)
#pragma unroll
                for (int i = 0; i < 16; ++i) xch[((qsub * 4 + d) * 16 + i) * 64 + lane] = O[d][i] * f; }
        __syncthreads();
        if (map == 0) {
            float ss = 0.f;
#pragma unroll
            for (int d = 0; d < 4; ++d)
#pragma unroll
                for (int i = 0; i < 16; ++i) { const float o = O[d][i] * inv - xch[((qsub * 4 + d) * 16 + i) * 64 + lane]; O[d][i] = o; ss += o * o; }
            ss += __shfl_xor(ss, 32);
            const float rn = (1.f / sqrtf(ss * (1.f / 128.f) + 1e-6f)) * (1.f - lambda_init);
            bf16_t* orow = ob + (size_t)(b * SEQ + q0 + rr) * 1024 + hd * 128;
#pragma unroll
            for (int d = 0; d < 4; ++d)
#pragma unroll
                for (int gq = 0; gq < 4; ++gq) { const int dv0 = d * 32 + 8 * gq + 4 * hh; const f32x4 g4 = *(const f32x4*)(subg + dv0);
                    u32x2 w; w.x = pk2(O[d][4 * gq] * rn * g4.x, O[d][4 * gq + 1] * rn * g4.y); w.y = pk2(O[d][4 * gq + 2] * rn * g4.z, O[d][4 * gq + 3] * rn * g4.w);
                    *(u32x2*)(orow + dv0) = w; }
        }
        __syncthreads();
    }
}

DI void dil_attn_phase(int wv, const bf16_t* qk, const bf16_t* vt, float* oacc, float* stats, bf16_t* ob, int g, int dil) {
    const int tid = mk_tid(wv), wid = __builtin_amdgcn_readfirstlane(tid >> 6), lane = tid & 63, rr = lane & 31, hh = lane >> 5; const int bid = opaque_bid();
    const int L = SEQ / dil, ntl = L / 32; const int prr = (rr & 0x13) | ((rr & 4) << 1) | ((rr & 8) >> 1);
    const float c1 = 0.08838834764831845f * LOG2E;
    for (int task = bid * 8 + wid; task < 8192; task += gridDim.x * 8) {
        const int lt = task % ntl; int t2 = task / ntl; const int head = t2 & 7; t2 >>= 3; const int rph = t2 % dil, b = t2 / dil;
        const int l0 = lt * 32;
        const float slope2d = exp2f(-(float)(head + 1)) * LOG2E * (float)dil;
        const size_t qrow = (size_t)b * SEQ + (size_t)(l0 + rr) * dil + rph;
        bf16x8 qf[8];
#pragma unroll
        for (int ks = 0; ks < 8; ++ks) qf[ks] = *(const bf16x8*)(qk + qrow * 2048 + head * 128 + ks * 16 + hh * 8);
        f32x16 O[4];
#pragma unroll
        for (int d = 0; d < 4; ++d) O[d] = zero16();
        float m = -INFINITY, l = 0.f;
        for (int jt = 0; jt < 5; ++jt) {
            const int kl0 = l0 - 128 + 32 * jt;
            if (kl0 < 0) continue;
            const size_t krow = (size_t)b * SEQ + (size_t)(kl0 + prr) * dil + rph;
            bf16x8 kf[8];
#pragma unroll
            for (int ks = 0; ks < 8; ++ks) kf[ks] = *(const bf16x8*)(qk + krow * 2048 + 1024 + head * 128 + ks * 16 + hh * 8);
            const bf16_t* vb = vt + (size_t)(head * 128 + rr) * M_TOK + (size_t)b * SEQ + (size_t)rph * L + kl0 + 8 * hh;
            bf16x8 vf[4][2];
#pragma unroll
            for (int d = 0; d < 4; ++d)
#pragma unroll
                for (int s = 0; s < 2; ++s) vf[d][s] = *(const bf16x8*)(vb + (size_t)d * 32 * M_TOK + 16 * s);
            f32x16 S = zero16();
#pragma unroll
            for (int ks = 0; ks < 8; ++ks) S = MFMA32(kf[ks], qf[ks], S);
            float sv[16]; float mx = -INFINITY;
#pragma unroll
            for (int i = 0; i < 16; ++i) { const int dist = (l0 + rr) - (kl0 + (i & 7) + 16 * (i >> 3) + 8 * hh); float v = S[i] * c1 - slope2d * (float)dist; v = (dist >= 0 && dist <= 128) ? v : -INFINITY; sv[i] = v; mx = fmaxf(mx, v); }
            mx = fmaxf(mx, __shfl_xor(mx, 32));
            const float mn = fmaxf(m, mx), alpha = fexp2(m - mn); m = mn;
            float ps = 0.f; f32x16 P;
#pragma unroll
            for (int i = 0; i < 16; ++i) { const float pv = fexp2(sv[i] - mn); P[i] = pv; ps += pv; }
            l = l * alpha + ps;
#pragma unroll
            for (int d = 0; d < 4; ++d) O[d] = O[d] * alpha;
            const bf16x8 pf0 = pack8(P, 0), pf1 = pack8(P, 1);
#pragma unroll
            for (int d = 0; d < 4; ++d) { O[d] = MFMA32(vf[d][0], pf0, O[d]); O[d] = MFMA32(vf[d][1], pf1, O[d]); }
        }
        const float ltot = l + __shfl_xor(l, 32), inv = 1.f / ltot, lse2 = m + log2f(ltot);
        float* st = stats + (qrow * 8 + head) * 2;
        float a = 0.f, bw = 1.f, lrun = 1.f, mrun = lse2;
        if (g > 0) { const float m0 = st[0], lr0 = st[1]; const float mn = fmaxf(m0, lse2); a = fexp2(m0 - mn); bw = fexp2(lse2 - mn); lrun = lr0 * a + bw; mrun = mn; }
        float* orow = oacc + qrow * 1024 + head * 128;
        bf16_t* obrow = ob + qrow * 1024 + head * 128;
        const float f = inv * bw, il = 1.f / lrun;
#pragma unroll
        for (int d = 0; d < 4; ++d)
#pragma unroll
            for (int gq = 0; gq < 4; ++gq) { const int dv0 = d * 32 + 8 * gq + 4 * hh;
                f32x4 o = {O[d][4 * gq] * f, O[d][4 * gq + 1] * f, O[d][4 * gq + 2] * f, O[d][4 * gq + 3] * f};
                if (g > 0) { const f32x4 old = *(const f32x4*)(orow + dv0); o = o + old * a; }
                if (g < 2) *(f32x4*)(orow + dv0) = o;
                else { u32x2 w; w.x = pk2(o.x * il, o.y * il); w.y = pk2(o.z * il, o.w * il); *(u32x2*)(obrow + dv0) = w; } }
        if (g < 2 && hh == 0) { st[0] = mrun; st[1] = lrun; }
    }
}

DI float logsig(float z) { return fminf(z, 0.f) - __logf(1.f + __expf(-fabsf(z))); }
DI void gla_gate_phase(int wv, LAS unsigned char* lds, const float* x, const float* w_in, const float* w2, const float* bg, const bf16_t* qk1,
                       bf16_t* qd, bf16_t* ki, bf16_t* kst, float* decay, bf16_t* sbuf) {
    const int tid = mk_tid(wv), wid = tid >> 6, lane = tid & 63, rr = lane & 31, hh = lane >> 5; const int bid = opaque_bid();
    LAS float* wg = (LAS float*)lds;
    LAS float* gl = (LAS float*)(lds + 65536);
#pragma unroll
    for (int i = 0; i < 8; ++i) { const int idx = tid + 512 * i, k = idx >> 2, n4 = (idx & 3) * 4; *(LAS f32x4*)(wg + k * 16 + n4) = *(const f32x4*)(w_in + (size_t)k * 3088 + 3072 + n4); }
    __syncthreads();
    const int c = tid;
    float w2c[16];
#pragma unroll
    for (int j = 0; j < 16; ++j) w2c[j] = w2[j * 512 + c];
    const float bc = bg[c];
    for (int it = bid; it < 512; it += gridDim.x) {
        const int b = it >> 6, ch = it & 63; const size_t T0 = (size_t)b * SEQ + ch * 64;
        for (int tt = 0; tt < 8; tt += 2) {
            const size_t t0 = T0 + wid * 8 + tt;
            float a0[16], a1[16];
#pragma unroll
            for (int n = 0; n < 16; ++n) { a0[n] = 0.f; a1[n] = 0.f; }
#pragma unroll
            for (int i = 0; i < 16; ++i) { const int k = lane + 64 * i; const float x0 = x[t0 * DM + k], x1 = x[(t0 + 1) * DM + k];
#pragma unroll
                for (int q = 0; q < 4; ++q) { const f32x4 w = *(const LAS f32x4*)(wg + k * 16 + 4 * q);
                    a0[4 * q] += x0 * w.x; a0[4 * q + 1] += x0 * w.y; a0[4 * q + 2] += x0 * w.z; a0[4 * q + 3] += x0 * w.w;
                    a1[4 * q] += x1 * w.x; a1[4 * q + 1] += x1 * w.y; a1[4 * q + 2] += x1 * w.z; a1[4 * q + 3] += x1 * w.w; } }
            float v0 = 0.f, v1 = 0.f;
#pragma unroll
            for (int n = 0; n < 16; ++n) { const float s0 = wave_sum(a0[n]), s1 = wave_sum(a1[n]); v0 = (lane == n) ? s0 : v0; v1 = (lane == n) ? s1 : v1; }
            if (lane < 16) { gl[(wid * 8 + tt) * 16 + lane] = v0; gl[(wid * 8 + tt + 1) * 16 + lane] = v1; }
        }
        __syncthreads();
        float cum = 0.f;
#pragma unroll 4
        for (int t = 0; t < 64; ++t) { float z = bc;
#pragma unroll
            for (int q = 0; q < 4; ++q) { const f32x4 gv = *(const LAS f32x4*)(gl + t * 16 + 4 * q); z += gv.x * w2c[4 * q] + gv.y * w2c[4 * q + 1] + gv.z * w2c[4 * q + 2] + gv.w * w2c[4 * q + 3]; }
            cum += logsig(z) * 0.0625f; }
        const float blast = cum;
        decay[((size_t)b * 64 + ch) * 512 + c] = __expf(blast);
        cum = 0.f;
        for (int t8 = 0; t8 < 64; t8 += 8) {
            float ksv[8];
#pragma unroll
            for (int u = 0; u < 8; ++u) { const int t = t8 + u; float z = bc;
#pragma unroll
                for (int q = 0; q < 4; ++q) { const f32x4 gv = *(const LAS f32x4*)(gl + t * 16 + 4 * q); z += gv.x * w2c[4 * q] + gv.y * w2c[4 * q + 1] + gv.z * w2c[4 * q + 2] + gv.w * w2c[4 * q + 3]; }
                cum += logsig(z) * 0.0625f;
                const size_t tok = T0 + t;
                const float qv = bf2f(qk1[tok * 1024 + c]), kv = bf2f(qk1[tok * 1024 + 512 + c]);
                qd[tok * 512 + c] = f2bf(qv * 0.08838834764831845f * __expf(cum));
                ki[tok * 512 + c] = f2bf(kv * __expf(-cum));
                ksv[u] = kv * __expf(blast - cum); }
            u32x4 w; w.x = pk2(ksv[0], ksv[1]); w.y = pk2(ksv[2], ksv[3]); w.z = pk2(ksv[4], ksv[5]); w.w = pk2(ksv[6], ksv[7]);
            *(u32x4*)(kst + ((size_t)b * 512 + c) * SEQ + ch * 64 + t8) = w;
        }
        __syncthreads();
        const int hd = wid >> 1;
#pragma unroll
        for (int u = 0; u < 2; ++u) {
            const int tt2 = (wid & 1) * 2 + u, kt = tt2 >> 1, qt = tt2 & 1;
            f32x16 S = zero16();
            if (!(kt == 1 && qt == 0)) {
#pragma unroll
                for (int ks = 0; ks < 8; ++ks) { const bf16x8 A = *(const bf16x8*)(ki + (T0 + kt * 32 + rr) * 512 + hd * 128 + ks * 16 + hh * 8);
                    const bf16x8 B = *(const bf16x8*)(qd + (T0 + qt * 32 + rr) * 512 + hd * 128 + ks * 16 + hh * 8); S = MFMA32(A, B, S); } }
            const int q = qt * 32 + rr;
            bf16_t* srow = sbuf + (((size_t)b * 4 + hd) * 64 + ch) * 4096 + q * 64 + kt * 32;
#pragma unroll
            for (int gq = 0; gq < 4; ++gq) { const int k0 = 8 * gq + 4 * hh; float v[4];
#pragma unroll
                for (int e = 0; e < 4; ++e) v[e] = (kt * 32 + k0 + e <= q) ? S[4 * gq + e] : 0.f;
                u32x2 w; w.x = pk2(v[0], v[1]); w.y = pk2(v[2], v[3]); *(u32x2*)(srow + k0) = w; }
        }
    }
}
#define SCAN_BAR() do { asm volatile("s_waitcnt lgkmcnt(0)" ::: "memory"); __builtin_amdgcn_s_barrier(); asm volatile("" ::: "memory"); } while (0)
DI void gla_scan_phase(int wv, LAS unsigned char* lds, const bf16_t* qd, const bf16_t* kst, const bf16_t* sbuf, const bf16_t* vt, const float* decay, float* obuf) {
    const int tid = mk_tid(wv), wid = __builtin_amdgcn_readfirstlane(tid >> 6), lane = tid & 63, rr = lane & 31, hh = lane >> 5; const int bid = opaque_bid();
    LAS float* red = (LAS float*)lds;
    for (int task = bid; task < 256; task += gridDim.x) {
        const int dvs = task & 7, hd = (task >> 3) & 3, b = task >> 5;
        const bf16_t* vrow = vt + (size_t)(hd * 256 + dvs * 32) * M_TOK + (size_t)b * SEQ; const unsigned lv = (unsigned)(rr * M_TOK + 8 * hh);
        if (wid < 4) {
            const int kb = wid;
            f32x16 St = zero16();
            const bf16_t* krow = kst + ((size_t)b * 512 + hd * 128 + kb * 32) * SEQ; const unsigned lk = (unsigned)(rr * SEQ + 8 * hh);
            const bf16_t* qp0 = qd + (size_t)b * SEQ * 512 + hd * 128 + kb * 32; const unsigned lq = (unsigned)(rr * 512 + 4 * hh);
            const float* dp0 = decay + (size_t)b * 64 * 512 + hd * 128 + kb * 32; const unsigned ld_ = (unsigned)(4 * hh);
            const int qt = wid >> 1;
            bf16x8 vA[4], kA[4], qB[4]; f32x4 dc[4];
            bf16x8 nvA[4], nkA[4], nqB[4]; f32x4 ndc[4];
#define SCAN_LOADC(c_, vA_, kA_, qB_, dc_) do { \
            _Pragma("unroll") for (int ks = 0; ks < 4; ++ks) { vA_[ks] = *(const bf16x8*)(vrow + (lv + (unsigned)((c_) * 64 + 16 * ks))); kA_[ks] = *(const bf16x8*)(krow + (lk + (unsigned)((c_) * 64 + 16 * ks))); } \
            _Pragma("unroll") for (int s_ = 0; s_ < 2; ++s_) _Pragma("unroll") for (int q_ = 0; q_ < 2; ++q_) { const bf16_t* qp = qp0 + (lq + (unsigned)(((c_) * 64 + q_ * 32) * 512 + 16 * s_)); \
                qB_[2 * s_ + q_] = cat44(*(const s16x4*)qp, *(const s16x4*)(qp + 8)); } \
            _Pragma("unroll") for (int gq = 0; gq < 4; ++gq) dc_[gq] = *(const f32x4*)(dp0 + (ld_ + (unsigned)((c_) * 512 + 8 * gq))); } while (0)
#define SCAN_BODYC(c, vA, kA, qB, dc, nvA, nkA, nqB, ndc) do { \
            const int cn = (c) < 63 ? (c) + 1 : 63; \
            SCAN_LOADC(cn, nvA, nkA, nqB, ndc); \
            LAS float* rb = red + ((c) & 1) * (5 * 2 * 16 * 64); \
            { f32x16 O0 = zero16(), O1 = zero16(); \
              _Pragma("unroll") for (int s_ = 0; s_ < 2; ++s_) { const bf16x8 stA = pack8(St, s_); O0 = MFMA32(stA, qB[2 * s_], O0); O1 = MFMA32(stA, qB[2 * s_ + 1], O1); } \
              LAS float* wp = rb + (wid * 2 * 16) * 64 + lane; \
              _Pragma("unroll") for (int i = 0; i < 16; ++i) { wp[i * 64] = O0[i]; wp[(16 + i) * 64] = O1[i]; } } \
            _Pragma("unroll") for (int gq = 0; gq < 4; ++gq) { St[4 * gq] *= dc[gq].x; St[4 * gq + 1] *= dc[gq].y; St[4 * gq + 2] *= dc[gq].z; St[4 * gq + 3] *= dc[gq].w; } \
            _Pragma("unroll") for (int ks = 0; ks < 4; ++ks) St = MFMA32(kA[ks], vA[ks], St); \
            SCAN_BAR(); \
            { const size_t T0 = (size_t)b * SEQ + (c) * 64; \
              _Pragma("unroll") for (int g2 = 0; g2 < 2; ++g2) { const int gq = 2 * (wid & 1) + g2; f32x4 acc = {0.f, 0.f, 0.f, 0.f}; \
                _Pragma("unroll") for (int sl = 0; sl < 5; ++sl) \
                    _Pragma("unroll") for (int e = 0; e < 4; ++e) acc[e] += rb[((sl * 2 + qt) * 16 + 4 * gq + e) * 64 + lane]; \
                *(f32x4*)(obuf + (T0 + qt * 32 + rr) * 1024 + hd * 256 + dvs * 32 + 8 * gq + 4 * hh) = acc; } } } while (0)
            SCAN_LOADC(0, vA, kA, qB, dc);
#pragma nounroll
            for (int c = 0; c < 64; c += 2) {
                SCAN_BODYC(c, vA, kA, qB, dc, nvA, nkA, nqB, ndc);
                SCAN_BODYC(c + 1, nvA, nkA, nqB, ndc, vA, kA, qB, dc);
            }
#undef SCAN_BODYC
#undef SCAN_LOADC
        } else if (wid == 4) {
            const bf16_t* sb0 = sbuf + ((size_t)b * 4 + hd) * 64 * 4096; const unsigned ls = (unsigned)(rr * 64 + 8 * hh);
            bf16x8 vA[4], sB[6], nvA[4], nsB[6];
#define SCAN_LOADI(c_, vA_, sB_) do { \
            _Pragma("unroll") for (int ks = 0; ks < 4; ++ks) vA_[ks] = *(const bf16x8*)(vrow + (lv + (unsigned)((c_) * 64 + 16 * ks))); \
            _Pragma("unroll") for (int ks = 0; ks < 2; ++ks) sB_[ks] = *(const bf16x8*)(sb0 + (ls + (unsigned)((c_) * 4096 + 16 * ks))); \
            _Pragma("unroll") for (int ks = 0; ks < 4; ++ks) sB_[2 + ks] = *(const bf16x8*)(sb0 + (ls + (unsigned)((c_) * 4096 + 32 * 64 + 16 * ks))); } while (0)
#define SCAN_BODYI(c, vA, sB, nvA, nsB) do { \
            const int cn = (c) < 63 ? (c) + 1 : 63; \
            SCAN_LOADI(cn, nvA, nsB); \
            LAS float* rb = red + ((c) & 1) * (5 * 2 * 16 * 64); \
            f32x16 O0 = zero16(), O1 = zero16(); \
            O0 = MFMA32(vA[0], sB[0], O0); O0 = MFMA32(vA[1], sB[1], O0); \
            _Pragma("unroll") for (int ks = 0; ks < 4; ++ks) O1 = MFMA32(vA[ks], sB[2 + ks], O1); \
            LAS float* wp = rb + (4 * 2 * 16) * 64 + lane; \
            _Pragma("unroll") for (int i = 0; i < 16; ++i) { wp[i * 64] = O0[i]; wp[(16 + i) * 64] = O1[i]; } \
            SCAN_BAR(); } while (0)
            SCAN_LOADI(0, vA, sB);
#pragma nounroll
            for (int c = 0; c < 64; c += 2) {
                SCAN_BODYI(c, vA, sB, nvA, nsB);
                SCAN_BODYI(c + 1, nvA, nsB, vA, sB);
            }
#undef SCAN_BODYI
#undef SCAN_LOADI
        } else {
#pragma nounroll
            for (int c = 0; c < 64; ++c) SCAN_BAR();
        }
        __syncthreads();
    }
}
#undef SCAN_BAR
DI void gla_finish_phase(int wv, const float* obuf, const bf16_t* rb, const float* gn, bf16_t* ob) {
    const int tid = mk_tid(wv), wid = tid >> 6, lane = tid & 63; const int bid = opaque_bid();
    const f32x4 g4 = ((const f32x4*)gn)[lane];
    const int nw = gridDim.x * 8;
    for (int row0 = bid * 8 + wid; row0 < M_TOK; row0 += 2 * nw) {
        f32x4 v[2][4]; u32x2 rw[2][4];
#pragma unroll
        for (int u = 0; u < 2; ++u) { const int row = (row0 + u * nw < M_TOK) ? row0 + u * nw : row0;
#pragma unroll
            for (int i = 0; i < 4; ++i) { v[u][i] = ((const f32x4*)(obuf + (size_t)row * 1024))[lane + 64 * i]; rw[u][i] = ((const u32x2*)(rb + (size_t)row * 1024))[lane + 64 * i]; } }
#pragma unroll
        for (int u = 0; u < 2; ++u) { const int row = row0 + u * nw; if (row < M_TOK) {
#pragma unroll
            for (int i = 0; i < 4; ++i) {
                const f32x4 x = v[u][i];
                const float ss = wave_sum((x.x * x.x + x.y * x.y) + (x.z * x.z + x.w * x.w));
                const float rn = 1.f / sqrtf(ss * (1.f / 256.f) + 1e-6f);
                const u32x2 r_ = rw[u][i];
                const float r0 = __uint_as_float(r_.x << 16), r1 = __uint_as_float(r_.x & 0xffff0000u), r2 = __uint_as_float(r_.y << 16), r3 = __uint_as_float(r_.y & 0xffff0000u);
                const float s0 = r0 / (1.f + expf(-r0)), s1 = r1 / (1.f + expf(-r1)), s2 = r2 / (1.f + expf(-r2)), s3 = r3 / (1.f + expf(-r3));
                u32x2 w; w.x = pk2(x.x * rn * g4.x * s0, x.y * rn * g4.y * s1); w.y = pk2(x.z * rn * g4.z * s2, x.w * rn * g4.w * s3);
                ((u32x2*)(ob + (size_t)row * 1024))[lane + 64 * i] = w;
            } } }
    }
}

DI unsigned xcc_id() { return (unsigned)__builtin_amdgcn_s_getreg((3 << 11) | 20) & 0xFu; }
DI void grid_barrier(int wv, unsigned* bar_, unsigned k, LAS unsigned* stash) {
    unsigned* bar = (unsigned*)opq((unsigned char*)bar_);
    asm volatile("s_waitcnt vmcnt(0) lgkmcnt(0)" ::: "memory");
    __syncthreads();
    if (mk_tid(wv) == 0) {
        const unsigned xcc = xcc_id(), nx = stash[0], nxcc = stash[1];
        const unsigned old = __hip_atomic_fetch_add(bar + 64 * (17 + xcc), 1u, __ATOMIC_RELAXED, __HIP_MEMORY_SCOPE_AGENT);
        if (old == k * nx - 1u) {
            __builtin_amdgcn_fence(__ATOMIC_RELEASE, "agent");
            asm volatile("s_waitcnt vmcnt(0)" ::: "memory");
            const unsigned old2 = __hip_atomic_fetch_add(bar + 64 * 33, 1u, __ATOMIC_RELAXED, __HIP_MEMORY_SCOPE_AGENT);
            if (old2 == k * nxcc - 1u) __hip_atomic_store(bar + 64 * 34, k, __ATOMIC_RELAXED, __HIP_MEMORY_SCOPE_AGENT);
        }
        while (__hip_atomic_load(bar + 64 * 34, __ATOMIC_RELAXED, __HIP_MEMORY_SCOPE_AGENT) < k) __builtin_amdgcn_s_sleep(2);
        __builtin_amdgcn_fence(__ATOMIC_ACQUIRE, "agent");
        asm volatile("s_waitcnt vmcnt(0)" ::: "memory");
    }
    __syncthreads();
}

__global__ void __launch_bounds__(512) mega(Params p) {
    extern __shared__ __attribute__((aligned(16))) unsigned char shm[];
    LAS unsigned char* lds = (LAS unsigned char*)shm;
    cg::grid_group grid = cg::this_grid();
    const int wv = __builtin_amdgcn_readfirstlane((int)threadIdx.x >> 6);
    int ph = 0; unsigned nbar = 0;
    LAS unsigned* stash = (LAS unsigned*)(lds + LDS_PHASE_BYTES);
#define xb ((bf16_t*)(opq(p.ws) + XB_OFF))
#define wb ((bf16_t*)(opq(p.ws) + WB_OFF))
#define scr (opq(p.ws) + SCR_OFF)
#define barctr ((unsigned*)(opq(p.ws) + BAR_OFF))
#define STT ((float*)(opq(p.ws) + BAR_OFF + 65536))
    float* X = p.out;
    if (mk_tid(wv) == 0) __hip_atomic_fetch_add(barctr + 64 * (1 + xcc_id()), 1u, __ATOMIC_RELAXED, __HIP_MEMORY_SCOPE_AGENT);
#define PH_BEGIN if (ph >= p.ph_lo && ph < p.ph_hi) {
#define PH_END   if (ph + 1 < p.ph_hi) { if (ph == p.ph_lo) { grid.sync(); \
        if (mk_tid(wv) == 0) { unsigned nx_ = __hip_atomic_load(barctr + 64 * (1 + xcc_id()), __ATOMIC_RELAXED, __HIP_MEMORY_SCOPE_AGENT), nxcc_ = 0; \
            for (int x_ = 0; x_ < 16; ++x_) nxcc_ += __hip_atomic_load(barctr + 64 * (1 + x_), __ATOMIC_RELAXED, __HIP_MEMORY_SCOPE_AGENT) != 0u ? 1u : 0u; \
            stash[0] = nx_; stash[1] = nxcc_; } } \
        else { ++nbar; grid_barrier(wv, barctr, nbar, stash); } } } ++ph;
    PH_BEGIN
        xconvert(wv, p.in[0], xb);
        wprep_layer(wv, lds, p, 0, wb);
    PH_END
#pragma nounroll
    for (int layer = 0; layer < 4; ++layer) {
        const int kind = layer % 3, ib = layer_base(layer), wo = wout_idx(layer);
        const int nin = kind == 1 ? 9216 : 3072;
        bf16_t* wb_out = wb + (size_t)nin * 1024; bf16_t* wb_1 = wb_out + 1024 * 1024; bf16_t* wb_2 = wb_1 + 4096 * 1024;
        bf16_t* QK = (bf16_t*)scr;
        bf16_t* VT = (bf16_t*)(scr + (kind == 2 ? 192 : 128) * MiB);
        bf16_t* OB = (bf16_t*)(scr + 192 * MiB);
        float* OACC = (float*)(scr + 256 * MiB); float* STATS = (float*)(scr + 384 * MiB);
        bf16_t* KI = (bf16_t*)(scr + 64 * MiB); float* OBUF = (float*)scr; bf16_t* RB = (bf16_t*)(scr + 128 * MiB);
        bf16_t* QD = (bf16_t*)(scr + 256 * MiB); bf16_t* KST = (bf16_t*)(scr + 288 * MiB); bf16_t* SB = (bf16_t*)(scr + 320 * MiB); float* DEC = (float*)(scr + 336 * MiB);
        bf16_t* H = (bf16_t*)scr;
        const int ng = kind == 1 ? 3 : 1;
#pragma nounroll
        for (int g = 0; g < ng; ++g) {
            const int dil = kind == 1 ? (g == 0 ? 1 : g == 1 ? 4 : 16) : 1;
            PH_BEGIN
                const int ngemm = kind == 2 ? 3 : 2;
#pragma nounroll
                for (int rep = 0; rep < REP_MIXG; ++rep)
#pragma nounroll
                for (int gi = 0; gi < ngemm; ++gi) {
                    GemmD d; EpiBf16<0> E;
                    d.K = 1024; d.dil = 1; d.L = 4096;
                    const bf16_t* wg_ = wb + (size_t)g * 3072 * 1024;
                    const bool isvt = (gi == ngemm - 1);
                    if (!isvt) {
                        d.A = xb; d.lda = 1024; d.ldb = 1024; d.nM = 128;
                        if (kind == 2) { d.Bt = wg_ + (size_t)(gi == 0 ? 0 : 2048) * 1024; d.nN = 4; E.O = gi == 0 ? QK : RB; E.ldc = 1024; }
                        else { d.Bt = wg_; d.nN = 8; E.O = QK; E.ldc = 2048; }
                    } else {
                        d.A = wg_ + (size_t)(kind == 2 ? 1024 : 2048) * 1024; d.lda = 1024; d.nM = 4;
                        d.Bt = xb; d.ldb = 1024; d.nN = 128; d.dil = dil; d.L = 4096 / dil; E.O = VT; E.ldc = M_TOK;
                    }
                    gemm_phase(wv, lds, d, E);
                }
            PH_END
            if (kind == 0) {
                PH_BEGIN
                    for (int rep = 0; rep < REP_DIFF; ++rep) diff_attn_phase(wv, lds, QK, VT, OB, p.in[ib + 1], p.in[ib + 2], p.in[ib + 3], p.in[ib + 4], p.in[ib + 5], layer);
                PH_END
            } else if (kind == 1) {
                PH_BEGIN
                    for (int rep = 0; rep < (g == 0 ? REP_DIL0 : 1); ++rep) { if (rep) __syncthreads(); dil_attn_phase(wv, QK, VT, OACC, STATS, OB, g, dil); }
                PH_END
            } else {
                PH_BEGIN
                    for (int rep = 0; rep < REP_GATE; ++rep) { if (rep) __syncthreads(); gla_gate_phase(wv, lds, X, p.in[ib], p.in[ib + 1], p.in[ib + 2], QK, QD, KI, KST, DEC, SB); }
                PH_END
                PH_BEGIN
                    for (int rep = 0; rep < REP_SCAN; ++rep) gla_scan_phase(wv, lds, QD, KST, SB, VT, DEC, OBUF);
                PH_END
                PH_BEGIN
                    gla_finish_phase(wv, OBUF, RB, p.in[ib + 3], OB);
                PH_END
            }
        }
#pragma nounroll
        for (int sub = 0; sub < 2; ++sub) {
            if (sub == 1) {
                PH_BEGIN
                    GemmD d; EpiBf16<1> E;
                    d.A = xb; d.lda = 1024; d.Bt = wb_1; d.ldb = 1024; d.K = 1024; d.nM = 128; d.nN = 16; d.dil = 1; d.L = 4096; E.O = H; E.ldc = 4096;
#pragma nounroll
                    for (int rep = 0; rep < REP_FFN1; ++rep) gemm_phase(wv, lds, d, E);
                PH_END
            }
            PH_BEGIN
                GemmD d; EpiBf16<0> E;
                d.A = sub == 0 ? OB : H; d.lda = sub == 0 ? 1024 : 4096; d.Bt = sub == 0 ? wb_out : wb_2; d.ldb = d.lda; d.K = d.lda; d.nM = 128; d.nN = 4; d.dil = 1; d.L = 4096;
                E.O = (bf16_t*)(scr + 256 * MiB); E.ldc = 1024;
                gemm_phase(wv, lds, d, E);
            PH_END
            PH_BEGIN
                ln_phase(wv, (const bf16_t*)(scr + 256 * MiB), ((layer == 3 || layer == 1) && sub == 1) ? X : nullptr, p.in[wo + 1 + 4 * sub], p.in[wo + 2 + 4 * sub], xb);
                if (sub == 1 && layer < 3) for (int rep = 0; rep < REP_PREP; ++rep) { if (rep) __syncthreads(); wprep_layer(wv, lds, p, layer + 1, wb); }
            PH_END
        }
    }
}

#undef xb
#undef wb
#undef scr
#undef barctr
#undef STT
extern "C" void kernel_launch(void* const* d_in, const int* in_sizes, int n_in, void* d_out, int out_size, void* d_ws, size_t ws_size, hipStream_t stream) {
    static int grid = 0;
    if (grid == 0) {
        if (n_in != 46 || ws_size < WS_NEED) { fprintf(stderr, "kernel_launch: unexpected n_in %d or ws_size %zu\n", n_in, ws_size); grid = -1; return; }
        int dev = 0, cus = 0, per_cu = 0;
        hipGetDevice(&dev);
        hipDeviceGetAttribute(&cus, hipDeviceAttributeMultiprocessorCount, dev);
        hipFuncSetAttribute((const void*)mega, hipFuncAttributeMaxDynamicSharedMemorySize, LDS_BYTES);
        hipOccupancyMaxActiveBlocksPerMultiprocessor(&per_cu, (const void*)mega, 512, LDS_BYTES);
        if (per_cu < 1) { fprintf(stderr, "kernel_launch: occupancy query says %d blocks per CU\n", per_cu); per_cu = 1; }
        (void)hipGetLastError();
        grid = cus * per_cu;
    }
    if (grid < 0) return;
    Params p{};
    for (int i = 0; i < 46; ++i) p.in[i] = (const float*)d_in[i];
    p.out = (float*)d_out; p.ws = (unsigned char*)d_ws;
#if MULTI_LAUNCH
    for (int ph = 0; ph < NPH; ++ph) { p.ph_lo = ph; p.ph_hi = ph + 1; hipLaunchKernelGGL(mega, dim3(grid), dim3(512), LDS_BYTES, stream, p); }
#else
    p.ph_lo = 0; p.ph_hi = NPH;
    (void)hipMemsetAsync((unsigned char*)d_ws + BAR_OFF, 0, 16384, stream);
    void* args[] = {&p};
    hipError_t e = hipLaunchCooperativeKernel((const void*)mega, dim3(grid), dim3(512), args, LDS_BYTES, stream);
    if (e != hipSuccess) fprintf(stderr, "cooperative launch failed: %s (grid %d)\n", hipGetErrorString(e), grid);
#endif
}
```

```cpp
#include <hip/hip_runtime.h>
#include <hip/hip_cooperative_groups.h>
#include <cstdio>
namespace cg = cooperative_groups;

#ifndef MULTI_LAUNCH
#define MULTI_LAUNCH 0
#endif

#define REP_MIXG 1
#define REP_FFN1 1
#define REP_DIL0 1
#define REP_GATE 1
#define REP_SCAN 1
#define REP_DIFF 1
#define REP_PREP 1
#define DI __device__ __forceinline__
#define LAS __attribute__((address_space(3)))
typedef unsigned short bf16_t;
typedef short bf16x8 __attribute__((ext_vector_type(8)));
typedef short s16x4 __attribute__((ext_vector_type(4)));
typedef float f32x2 __attribute__((ext_vector_type(2)));
typedef float f32x4 __attribute__((ext_vector_type(4)));
typedef float f32x16 __attribute__((ext_vector_type(16)));
typedef unsigned u32x2 __attribute__((ext_vector_type(2)));
typedef unsigned u32x4 __attribute__((ext_vector_type(4)));
typedef __bf16 bf2_t __attribute__((ext_vector_type(2)));

constexpr int M_TOK = 32768, DM = 1024, SEQ = 4096, NPH = 35;
constexpr float LOG2E = 1.4426950408889634f;
constexpr float ALPHA_RES = 1.681792830507429f;
constexpr size_t MiB = 1024 * 1024;
constexpr size_t XB_OFF = 0, WB_OFF = 64 * MiB, SCR_OFF = 104 * MiB, BAR_OFF = 491 * MiB, WS_NEED = 492 * MiB;
constexpr int LDS_PHASE_BYTES = 131072, LDS_BYTES = LDS_PHASE_BYTES + 256;

struct Params {
    const float* in[46];
    float* out;
    unsigned char* ws;
    int ph_lo, ph_hi;
};

DI unsigned pk2(float lo, float hi) { f32x2 f = {lo, hi}; bf2_t v = __builtin_convertvector(f, bf2_t); return __builtin_bit_cast(unsigned, v); }
DI bf16_t f2bf(float x) { return (bf16_t)(pk2(x, 0.f) & 0xffffu); }
DI float bf2f(bf16_t v) { return __uint_as_float(((unsigned)v) << 16); }
DI float wave_sum(float v) {
#pragma unroll
    for (int o = 1; o < 64; o <<= 1) v += __shfl_xor(v, o);
    return v;
}
DI int mk_tid(int wv) { int w = wv; asm volatile("" : "+s"(w)); int l = __builtin_amdgcn_mbcnt_hi(~0u, __builtin_amdgcn_mbcnt_lo(~0u, 0u)); asm volatile("" : "+v"(l)); return w * 64 + l; }
DI size_t opq_off(size_t o) { asm volatile("" : "+s"(o)); return o; }
DI int opaque_bid() { int b = blockIdx.x; asm volatile("" : "+s"(b)); return b; }
DI float fexp2(float x) { return __builtin_amdgcn_exp2f(x); }
DI int crow(int i, int hh) { return (i & 3) + 8 * (i >> 2) + 4 * hh; }
#define MFMA32(a, b, c) __builtin_amdgcn_mfma_f32_32x32x16_bf16((a), (b), (c), 0, 0, 0)
DI bf16x8 cat44(s16x4 lo, s16x4 hi) { return __builtin_shufflevector(lo, hi, 0, 1, 2, 3, 4, 5, 6, 7); }
DI bf16x8 pack8(const f32x16& x, int s) {
    u32x4 w;
    w.x = pk2(x[8 * s + 0], x[8 * s + 1]); w.y = pk2(x[8 * s + 2], x[8 * s + 3]);
    w.z = pk2(x[8 * s + 4], x[8 * s + 5]); w.w = pk2(x[8 * s + 6], x[8 * s + 7]);
    return __builtin_bit_cast(bf16x8, w);
}
DI f32x16 zero16() { f32x16 z; for (int i = 0; i < 16; ++i) z[i] = 0.f; return z; }

constexpr int BM = 256, BK = 64, HALF = 128, HTB = HALF * BK * 2, NXCD = 8, WGM = 8;
DI int lds_byte(int r, int c) { const int st = (r >> 4) * 2 + (c >> 5), rr = r & 15, cc = c & 31, ob = rr * 64 + cc * 2; return st * 1024 + (ob ^ (((ob >> 9) & 1) << 5)); }
DI void stage_rc(int b, int& R, int& C) { const int st = b / 1024, sb = b % 1024, swz = sb ^ (((sb >> 9) & 1) << 5); R = (st >> 1) * 16 + swz / 64; C = (st & 1) * 32 + (swz % 64) / 2; }
DI int perm32(int rho) { const int n = rho >> 4, i = rho & 15; return 8 * (i >> 2) + 4 * n + (i & 3); }

struct Unit { int pm, pn; };
struct GemmD { const bf16_t* A; const bf16_t* Bt; int lda, ldb, K, nM, nN, dil, L; };
struct StaticOrder {
    int nM, nN, nwg, G, c;
    DI void init(int nM_, int nN_, int G_, int c_) { nM = nM_; nN = nN_; nwg = nM * nN; G = G_; c = c_; }
    DI bool next(int i, Unit& u) const {
        const long Lx = (long)i * G + c; if (Lx >= nwg) return false;
        int wgid = (int)Lx; { const int q = nwg / NXCD, r = nwg % NXCD, xcd = wgid % NXCD, off = wgid / NXCD; wgid = (xcd < r ? xcd * (q + 1) : r * (q + 1) + (xcd - r) * q) + off; }
        const int nig = WGM * nN, gid = wgid / nig, fm = gid * WGM, gsz = (nM - fm) < WGM ? (nM - fm) : WGM;
        u.pm = fm + ((wgid % nig) % gsz); u.pn = (wgid % nig) / gsz; return true;
    }
};

template <int ACT  > struct EpiBf16 {
    static constexpr bool PERM = true;
    bf16_t* O; size_t ldc;
    DI void operator()(const f32x4 (&acc)[2][2][4][2], const Unit& u, int wr, int wc, int fr, int fq) const {
        const int row0 = u.pm * BM + wr * 64 + fr; const int col0 = u.pn * BM + wc * 32 + 8 * fq;
#pragma unroll
        for (int ai = 0; ai < 2; ++ai)
#pragma unroll
            for (int m = 0; m < 4; ++m) { bf16_t* rowp = O + (size_t)(row0 + ai * HALF + m * 16) * ldc + col0;
#pragma unroll
                for (int bj = 0; bj < 2; ++bj) { f32x4 v0 = acc[ai][bj][m][0], v1 = acc[ai][bj][m][1];
                    if (ACT == 1) {
#pragma unroll
                        for (int j = 0; j < 4; ++j) { float a = fmaxf(v0[j], 0.f), b = fmaxf(v1[j], 0.f); v0[j] = a * a; v1[j] = b * b; } }
                    u32x4 w; w.x = pk2(v0[0], v0[1]); w.y = pk2(v0[2], v0[3]); w.z = pk2(v1[0], v1[1]); w.w = pk2(v1[2], v1[3]);
                    *(u32x4*)(rowp + bj * HALF) = w; } }
    }
};
struct EpiRes {
    static constexpr bool PERM = true;
    const bf16_t* res; bf16_t* out;
    DI void operator()(const f32x4 (&acc)[2][2][4][2], const Unit& u, int wr, int wc, int fr, int fq) const {
        const int row0 = u.pm * BM + wr * 64 + fr, col0 = u.pn * BM + wc * 32 + 8 * fq;
#pragma unroll
        for (int ai = 0; ai < 2; ++ai)
#pragma unroll
            for (int m = 0; m < 4; ++m) { const size_t ro = (size_t)(row0 + ai * HALF + m * 16) * DM + col0;
#pragma unroll
                for (int bj = 0; bj < 2; ++bj) { const u32x4 r = *(const u32x4*)(res + ro + bj * HALF);
                    const f32x4 v0 = acc[ai][bj][m][0], v1 = acc[ai][bj][m][1];
                    u32x4 w;
                    w.x = pk2(__uint_as_float(r.x << 16) * ALPHA_RES + v0[0], __uint_as_float(r.x & 0xffff0000u) * ALPHA_RES + v0[1]);
                    w.y = pk2(__uint_as_float(r.y << 16) * ALPHA_RES + v0[2], __uint_as_float(r.y & 0xffff0000u) * ALPHA_RES + v0[3]);
                    w.z = pk2(__uint_as_float(r.z << 16) * ALPHA_RES + v1[0], __uint_as_float(r.z & 0xffff0000u) * ALPHA_RES + v1[1]);
                    w.w = pk2(__uint_as_float(r.w << 16) * ALPHA_RES + v1[2], __uint_as_float(r.w & 0xffff0000u) * ALPHA_RES + v1[3]);
                    *(u32x4*)(out + ro + bj * HALF) = w; } }
    }
};

template <class Epi>
DI void gemm_phase(int wv, LAS unsigned char* lds, const GemmD g, const Epi& E) {
    const int tid = mk_tid(wv), wid = __builtin_amdgcn_readfirstlane(tid >> 6), lane = tid & 63, wr = wid >> 2, wc = wid & 3, fr = lane & 15, fq = lane >> 4;
    const int K = g.K, nt = K / BK;
    const int ldbe = g.ldb * g.dil;
    unsigned voffA[2], voffB[2];
#pragma unroll
    for (int i = 0; i < 2; ++i) { int R, C; stage_rc(tid * 16 + i * 8192, R, C); const int Rb = Epi::PERM ? ((R & ~31) + perm32(R & 31)) : R;
        voffA[i] = (unsigned)(R * g.lda + C) * 2u; voffB[i] = (unsigned)(Rb * ldbe + C) * 2u; }
    const size_t kstep = (size_t)(BK * 2);
    const size_t hstepA = (size_t)HALF * g.lda * 2, hstepB = (size_t)HALF * ldbe * 2;
    const unsigned ldsw = (unsigned)wid * 1024u;
    const int aoff = lds_byte(wr * 64 + fr, fq * 8), boff = lds_byte(wc * 32 + fr, fq * 8);
#define PG8_SA(b, h) (((b) * 2 + (h)) * HTB)
#define PG8_SB(b, h) ((4 + (b) * 2 + (h)) * HTB)
#define PG8_STAGE(bufoff, gbase, voff) do { _Pragma("unroll") for (int _i = 0; _i < 2; ++_i) \
        __builtin_amdgcn_global_load_lds((const unsigned*)((const char*)(gbase) + (voff)[_i]), (LAS unsigned*)(lds + (bufoff) + ldsw + _i * 8192), 16, 0, 0); } while (0)
#define PG8_LDA(dst, b, h) do { _Pragma("unroll") for (int m = 0; m < 4; ++m) _Pragma("unroll") for (int k = 0; k < 2; ++k) dst[m][k] = *(const LAS bf16x8*)(lds + PG8_SA(b, h) + aoff + m * 2048 + k * 1024); } while (0)
#define PG8_LDB(dst, b, h) do { _Pragma("unroll") for (int n = 0; n < 2; ++n) _Pragma("unroll") for (int k = 0; k < 2; ++k) dst[n][k] = *(const LAS bf16x8*)(lds + PG8_SB(b, h) + boff + n * 2048 + k * 1024); } while (0)
#define PG8_MMA(ai, bj, At, Bt) do { __builtin_amdgcn_s_setprio(1); _Pragma("unroll") for (int m = 0; m < 4; ++m) _Pragma("unroll") for (int n = 0; n < 2; ++n) _Pragma("unroll") for (int k = 0; k < 2; ++k) \
        acc[ai][bj][m][n] = __builtin_amdgcn_mfma_f32_16x16x32_bf16(Bt[n][k], At[m][k], acc[ai][bj][m][n], 0, 0, 0); __builtin_amdgcn_s_setprio(0); } while (0)
#define PG8_WAIT_V(n) asm volatile("s_waitcnt vmcnt(" #n ")" ::: "memory")
#define PG8_WAIT_L(n) asm volatile("s_waitcnt lgkmcnt(" #n ")" ::: "memory")
#define PG8_BAR __builtin_amdgcn_s_barrier()
#define PG8_SCHED __builtin_amdgcn_sched_barrier(0)
    StaticOrder S; S.init(g.nM, g.nN, (int)gridDim.x, opaque_bid());
    Unit cur, nxt; int ui = 0;
    if (!S.next(0, cur)) return;
    f32x4 acc[2][2][4][2];
#pragma unroll
    for (int a = 0; a < 2; ++a)
#pragma unroll
        for (int b = 0; b < 2; ++b)
#pragma unroll
            for (int m = 0; m < 4; ++m)
#pragma unroll
                for (int n = 0; n < 2; ++n) acc[a][b][m][n] = (f32x4){0.f, 0.f, 0.f, 0.f};
    bf16x8 At[4][2], B0[2][2], B1[2][2];
#define PG8_BROW(pn_) ({ const int p0_ = (pn_) * 256; const int bb_ = p0_ >> 12, rem_ = p0_ & 4095, r_ = rem_ / g.L, l0_ = rem_ - r_ * g.L; (size_t)(bb_ * 4096 + l0_ * g.dil + r_); })
    const char* cA = (const char*)g.A + (size_t)cur.pm * 256 * g.lda * 2; const char* cB = (const char*)g.Bt + PG8_BROW(cur.pn) * (size_t)g.ldb * 2;
    PG8_STAGE(PG8_SB(0, 0), cB, voffB); PG8_STAGE(PG8_SA(0, 0), cA, voffA); PG8_STAGE(PG8_SB(0, 1), cB + hstepB, voffB); PG8_STAGE(PG8_SA(0, 1), cA + hstepA, voffA);
    if (wr == 1) PG8_BAR;
    PG8_WAIT_V(4); PG8_BAR;
    PG8_STAGE(PG8_SB(1, 0), cB + kstep, voffB); PG8_STAGE(PG8_SA(1, 0), cA + kstep, voffA); PG8_STAGE(PG8_SB(1, 1), cB + hstepB + kstep, voffB);
    PG8_WAIT_V(6); PG8_BAR;
    for (;;) {
        const bool has_next = S.next(ui + 1, nxt);
        const char* nA = has_next ? (const char*)g.A + (size_t)nxt.pm * 256 * g.lda * 2 : cA; const char* nB = has_next ? (const char*)g.Bt + PG8_BROW(nxt.pn) * (size_t)g.ldb * 2 : cB;
        for (int t = 0; t < nt; t += 2) {
            const bool last = (t == nt - 2);
            const char* a1 = cA + (size_t)(t + 1) * kstep;
            const char* a2 = last ? nA : cA + (size_t)(t + 2) * kstep; const char* b2 = last ? nB : cB + (size_t)(t + 2) * kstep;
            const char* a3 = a2 + kstep; const char* b3 = b2 + kstep;
            PG8_LDB(B0, 0, 0); PG8_SCHED; PG8_LDA(At, 0, 0); PG8_STAGE(PG8_SA(1, 1), a1 + hstepA, voffA);
            PG8_WAIT_L(8); PG8_BAR; PG8_WAIT_L(0); PG8_MMA(0, 0, At, B0); PG8_BAR; PG8_SCHED;
            PG8_LDB(B1, 0, 1); PG8_STAGE(PG8_SB(0, 0), b2, voffB);
            PG8_BAR; PG8_WAIT_L(0); PG8_MMA(0, 1, At, B1); PG8_BAR;
            PG8_LDA(At, 0, 1); PG8_STAGE(PG8_SA(0, 0), a2, voffA);
            PG8_BAR; PG8_WAIT_L(0); PG8_MMA(1, 0, At, B0); PG8_BAR; PG8_SCHED;
            PG8_STAGE(PG8_SB(0, 1), b2 + hstepB, voffB);
            PG8_WAIT_V(6); PG8_BAR; PG8_MMA(1, 1, At, B1); PG8_BAR;
            PG8_LDB(B0, 1, 0); PG8_SCHED; PG8_LDA(At, 1, 0); PG8_STAGE(PG8_SA(0, 1), a2 + hstepA, voffA);
            PG8_WAIT_L(8); PG8_BAR; PG8_WAIT_L(0); PG8_MMA(0, 0, At, B0); PG8_BAR; PG8_SCHED;
            PG8_LDB(B1, 1, 1); PG8_STAGE(PG8_SB(1, 0), b3, voffB);
            PG8_BAR; PG8_WAIT_L(0); PG8_MMA(0, 1, At, B1); PG8_BAR;
            PG8_LDA(At, 1, 1); PG8_STAGE(PG8_SA(1, 0), a3, voffA);
            PG8_BAR; PG8_WAIT_L(0); PG8_MMA(1, 0, At, B0); PG8_BAR; PG8_SCHED;
            PG8_STAGE(PG8_SB(1, 1), b3 + hstepB, voffB);
            PG8_WAIT_V(6); PG8_BAR; PG8_MMA(1, 1, At, B1); PG8_BAR;
        }
        E(acc, cur, wr, wc, fr, fq);
        if (!has_next) break;
#pragma unroll
        for (int a = 0; a < 2; ++a)
#pragma unroll
            for (int b = 0; b < 2; ++b)
#pragma unroll
                for (int m = 0; m < 4; ++m)
#pragma unroll
                    for (int n = 0; n < 2; ++n) acc[a][b][m][n] = (f32x4){0.f, 0.f, 0.f, 0.f};
        cur = nxt; cA = nA; cB = nB; ++ui;
    }
    PG8_WAIT_V(0);
    if (wr == 0) PG8_BAR;
    PG8_BAR;
#undef PG8_BROW
#undef PG8_SA
#undef PG8_SB
#undef PG8_STAGE
#undef PG8_LDA
#undef PG8_LDB
#undef PG8_MMA
#undef PG8_WAIT_V
#undef PG8_WAIT_L
#undef PG8_BAR
#undef PG8_SCHED
}

DI void transpose_item(const float* W, int K, int ldw, int nblk, bf16_t* WT, LAS float* scr, int item, int lane) {
    const int kb = item / nblk, nb = item % nblk, k0 = 64 * kb, n0 = 32 * nb;
    float wv_[32];
#pragma unroll
    for (int i = 0; i < 32; ++i) { const int kk = 2 * i + (lane >> 5); wv_[i] = W[(size_t)(k0 + kk) * ldw + n0 + (lane & 31)]; }
#pragma unroll
    for (int i = 0; i < 32; ++i) { const int kk = 2 * i + (lane >> 5); scr[kk * 33 + (lane & 31)] = wv_[i]; }
    asm volatile("s_waitcnt lgkmcnt(0)" ::: "memory");
    const int c = lane & 7;
#pragma unroll
    for (int j = 0; j < 4; ++j) { const int n = (lane >> 3) + 8 * j; const LAS float* s = scr + (8 * c) * 33 + n;
        u32x4 o; o.x = pk2(s[0 * 33], s[1 * 33]); o.y = pk2(s[2 * 33], s[3 * 33]); o.z = pk2(s[4 * 33], s[5 * 33]); o.w = pk2(s[6 * 33], s[7 * 33]);
        *(u32x4*)(WT + (size_t)(n0 + n) * K + k0 + 8 * c) = o; }
    asm volatile("s_waitcnt lgkmcnt(0)" ::: "memory");
}
DI int layer_base(int layer) { return layer == 0 ? 1 : layer == 1 ? 14 : layer == 2 ? 22 : 33; }
DI int wout_idx(int layer) { const int kind = layer % 3; return layer_base(layer) + (kind == 0 ? 6 : kind == 1 ? 1 : 4); }
DI void wprep_layer(int wv, LAS unsigned char* lds, const Params& p, int layer, bf16_t* wb) {
    const int kind = layer % 3, nin = kind == 1 ? 9216 : 3072, ldw_in = kind == 1 ? 9216 : kind == 2 ? 3088 : 3072;
    const int wo = wout_idx(layer);
    const float* w_in = p.in[layer_base(layer)]; const float* w_out = p.in[wo]; const float* w1 = p.in[wo + 3]; const float* w2 = p.in[wo + 4];
    bf16_t* wb_out = wb + (size_t)nin * 1024; bf16_t* wb_1 = wb_out + 1024 * 1024; bf16_t* wb_2 = wb_1 + 4096 * 1024;
    const int tid = mk_tid(wv), wid = tid >> 6, lane = tid & 63; const int bid = opaque_bid();
    LAS float* scr = (LAS float*)(lds + wid * 8448);
    const int I0 = 16 * (nin / 32), I1 = 16 * 32, I2 = 16 * 128, I3 = 64 * 32, tot = I0 + I1 + I2 + I3;
    for (int it = bid * 8 + wid; it < tot; it += gridDim.x * 8) {
        int r = it;
        if (r < I0) { transpose_item(w_in, 1024, ldw_in, nin / 32, wb, scr, r, lane); continue; } r -= I0;
        if (r < I1) { transpose_item(w_out, 1024, 1024, 32, wb_out, scr, r, lane); continue; } r -= I1;
        if (r < I2) { transpose_item(w1, 1024, 4096, 128, wb_1, scr, r, lane); continue; } r -= I2;
        transpose_item(w2, 4096, 1024, 32, wb_2, scr, r, lane);
    }
}
DI void xconvert(int wv, const float* x, bf16_t* xb) {
    const size_t n8 = (size_t)M_TOK * DM / 8;
    const size_t st_ = (size_t)gridDim.x * 512;
    for (size_t i = (size_t)opaque_bid() * 512 + mk_tid(wv); i < n8; i += 4 * st_) {
        f32x4 a[4], b[4];
#pragma unroll
        for (int u = 0; u < 4; ++u) { const size_t j = (i + u * st_ < n8) ? i + u * st_ : i; a[u] = ((const f32x4*)x)[2 * j]; b[u] = ((const f32x4*)x)[2 * j + 1]; }
#pragma unroll
        for (int u = 0; u < 4; ++u) if (i + u * st_ < n8) { u32x4 w; w.x = pk2(a[u].x, a[u].y); w.y = pk2(a[u].z, a[u].w); w.z = pk2(b[u].x, b[u].y); w.w = pk2(b[u].z, b[u].w);
            ((u32x4*)xb)[i + u * st_] = w; }
    }
}
DI void ln_phase(int wv, const bf16_t* y, float* xo, const float* g, const float* bta, bf16_t* xb) {
    const int tid = mk_tid(wv), wid = tid >> 6, lane = tid & 63; const int bid = opaque_bid();
    f32x4 gv[4], bv[4];
#pragma unroll
    for (int j = 0; j < 2; ++j) { gv[2 * j] = *(const f32x4*)(g + j * 512 + lane * 8); gv[2 * j + 1] = *(const f32x4*)(g + j * 512 + lane * 8 + 4);
                                  bv[2 * j] = *(const f32x4*)(bta + j * 512 + lane * 8); bv[2 * j + 1] = *(const f32x4*)(bta + j * 512 + lane * 8 + 4); }
    const int nw = gridDim.x * 8;
    constexpr int R = 4;
    for (int row0 = bid * 8 + wid; row0 < M_TOK; row0 += R * nw) {
        u32x4 raw[R][2], rsd[R][2];
#pragma unroll
        for (int r = 0; r < R; ++r) { const int row = (row0 + r * nw < M_TOK) ? row0 + r * nw : row0;
#pragma unroll
            for (int j = 0; j < 2; ++j) { raw[r][j] = *(const u32x4*)(y + (size_t)row * DM + j * 512 + lane * 8); rsd[r][j] = *(const u32x4*)(xb + (size_t)row * DM + j * 512 + lane * 8); } }
#pragma unroll
        for (int r = 0; r < R; ++r) {
            const int row = row0 + r * nw;
            if (row < M_TOK) {
                f32x4 v[4];
#pragma unroll
                for (int j = 0; j < 2; ++j) { const u32x4 q = raw[r][j], x_ = rsd[r][j];
                    v[2 * j] = (f32x4){__uint_as_float(q.x << 16), __uint_as_float(q.x & 0xffff0000u), __uint_as_float(q.y << 16), __uint_as_float(q.y & 0xffff0000u)}
                             + (f32x4){__uint_as_float(x_.x << 16), __uint_as_float(x_.x & 0xffff0000u), __uint_as_float(x_.y << 16), __uint_as_float(x_.y & 0xffff0000u)} * ALPHA_RES;
                    v[2 * j + 1] = (f32x4){__uint_as_float(q.z << 16), __uint_as_float(q.z & 0xffff0000u), __uint_as_float(q.w << 16), __uint_as_float(q.w & 0xffff0000u)}
                                 + (f32x4){__uint_as_float(x_.z << 16), __uint_as_float(x_.z & 0xffff0000u), __uint_as_float(x_.w << 16), __uint_as_float(x_.w & 0xffff0000u)} * ALPHA_RES; }
                float s_ = 0.f;
#pragma unroll
                for (int j = 0; j < 4; ++j) s_ += (v[j].x + v[j].y) + (v[j].z + v[j].w);
                const float mean = wave_sum(s_) * (1.f / DM); float s2 = 0.f;
#pragma unroll
                for (int j = 0; j < 4; ++j) { v[j] = v[j] - mean; s2 += (v[j].x * v[j].x + v[j].y * v[j].y) + (v[j].z * v[j].z + v[j].w * v[j].w); }
                const float rstd = 1.f / sqrtf(wave_sum(s2) * (1.f / DM) + 1e-5f);
#pragma unroll
                for (int j = 0; j < 2; ++j) { const f32x4 y0 = v[2 * j] * rstd * gv[2 * j] + bv[2 * j], y1 = v[2 * j + 1] * rstd * gv[2 * j + 1] + bv[2 * j + 1];
                    if (xo) { *(f32x4*)(xo + (size_t)row * DM + j * 512 + lane * 8) = y0; *(f32x4*)(xo + (size_t)row * DM + j * 512 + lane * 8 + 4) = y1; }
                    u32x4 w; w.x = pk2(y0.x, y0.y); w.y = pk2(y0.z, y0.w); w.z = pk2(y1.x, y1.y); w.w = pk2(y1.z, y1.w);
                    *(u32x4*)(xb + (size_t)row * DM + j * 512 + lane * 8) = w; }
            }
        }
    }
}

constexpr int DA_KP = 272, DA_VP = 144, DA_KB = 64 * DA_KP, DA_BUF = DA_KB + 128 * DA_VP;
DI void diff_attn_phase(int wv, LAS unsigned char* lds, const bf16_t* qk, const bf16_t* vt, bf16_t* ob, const float* lq1, const float* lk1, const float* lq2, const float* lk2,
                        const float* subg, int layer_idx) {
    const int tid = mk_tid(wv), wid = __builtin_amdgcn_readfirstlane(tid >> 6), lane = tid & 63, rr = lane & 31, hh = lane >> 5; const int bid = opaque_bid();
    const int map = wid >> 2, qsub = wid & 3;
    int li_ = layer_idx; asm volatile("" : "+s"(li_)); const float lambda_init = (li_ == 0) ? 0.2f : 0.5560582041f;
    const float d1 = wave_sum(lq1[lane] * lk1[lane]), d2 = wave_sum(lq2[lane] * lk2[lane]);
    const float lam = expf(d1) - expf(d2) + lambda_init;
    LAS float* xch = (LAS float*)lds;
    const float c1 = 0.125f * LOG2E;
    const int prr = (rr & 0x13) | ((rr & 4) << 1) | ((rr & 8) >> 1);
    const int koff = prr * DA_KP + (map * 64 + hh * 8) * 2;
    const int voff = DA_KB + rr * DA_VP + hh * 16;
    const int krow0 = tid >> 4, kch = tid & 15, vrow0 = tid >> 3, vch = tid & 7;
    const int kst_off = krow0 * DA_KP + kch * 16, vst_off = DA_KB + vrow0 * DA_VP + vch * 16;
    for (int it = bid; it < 2048; it += gridDim.x) {
        const int rho = it >> 8, j = it & 255, grp = j >> 6, bh = j & 63;
        const int qb = 28 - 4 * rho + ((rho & 1) ? grp : 3 - grp);
        const int b = bh >> 3, hd = bh & 7;
        const int q0 = qb * 128 + qsub * 32, nkt = 2 * qb + 2, qpos = q0 + rr;
        const float slope2 = exp2f(-(float)(hd + 1)) * LOG2E;
        const bf16_t* qkb = qk + (size_t)b * SEQ * 2048;
        LAS unsigned char* qlds = lds + 2 * DA_BUF + wid * 4096 + lane * 16;
#pragma unroll
        for (int ks = 0; ks < 4; ++ks) *(LAS bf16x8*)(qlds + ks * 1024) = *(const bf16x8*)(qkb + (size_t)(q0 + rr) * 2048 + hd * 128 + map * 64 + ks * 16 + hh * 8);
        const bf16_t* kg = qkb + 1024 + hd * 128 + kch * 8 + (size_t)krow0 * 2048;
        const bf16_t* vg = vt + (size_t)(hd * 128 + vrow0) * M_TOK + (size_t)b * SEQ + vch * 8;
        float cb[16];
#pragma unroll
        for (int i = 0; i < 16; ++i) cb[i] = slope2 * (float)((i & 7) + 16 * (i >> 3));
        f32x16 O[4];
#pragma unroll
        for (int d = 0; d < 4; ++d) O[d] = zero16();
        float m = -INFINITY, l = 0.f;
        u32x4 gk[2], gv[2];
#pragma unroll
        for (int i = 0; i < 2; ++i) { gk[i] = *(const u32x4*)(kg + (size_t)i * 32 * 2048); gv[i] = *(const u32x4*)(vg + (size_t)i * 64 * M_TOK); }
#pragma unroll
        for (int i = 0; i < 2; ++i) { *(LAS u32x4*)(lds + kst_off + i * 32 * DA_KP) = gk[i]; *(LAS u32x4*)(lds + vst_off + i * 64 * DA_VP) = gv[i]; }
        __syncthreads();
        const int tmain = 2 * qb;
#pragma nounroll
        for (int t = 0; t < tmain; ++t) {
            const int key0 = t * 64;
            const bool more = true;
            if (more) {
#pragma unroll
                for (int i = 0; i < 2; ++i) gk[i] = *(const u32x4*)(kg + (size_t)(key0 + 64 + i * 32) * 2048); }
            LAS unsigned char* buf = lds + (t & 1) * DA_BUF;
            {
                f32x16 S0 = zero16(), S1 = zero16();
                {
                    bf16x8 kf[2][4];
#pragma unroll
                    for (int sub = 0; sub < 2; ++sub)
#pragma unroll
                        for (int ks = 0; ks < 4; ++ks) kf[sub][ks] = *(const LAS bf16x8*)(buf + koff + sub * 32 * DA_KP + ks * 32);
#pragma unroll
                    for (int ks = 0; ks < 4; ++ks) { const bf16x8 qfr = *(const LAS bf16x8*)(qlds + ks * 1024); S0 = MFMA32(kf[0][ks], qfr, S0); S1 = MFMA32(kf[1][ks], qfr, S1); }
                }
                __builtin_amdgcn_sched_barrier(0);
#pragma unroll
                for (int i = 0; i < 2; ++i) gv[i] = *(const u32x4*)(vg + (size_t)i * 64 * M_TOK + key0 + 64);
                bf16x8 vf[4][2];
#pragma unroll
                for (int d = 0; d < 4; ++d)
#pragma unroll
                    for (int s2 = 0; s2 < 2; ++s2) vf[d][s2] = *(const LAS bf16x8*)(buf + voff + d * 32 * DA_VP + (16 * s2) * 2);
                const float base = slope2 * (float)(key0 + 8 * hh - qpos), b32 = 32.f * slope2;
#pragma unroll
                for (int i = 0; i < 16; ++i) { S0[i] = S0[i] * c1 + cb[i]; S1[i] = S1[i] * c1 + cb[i]; }
                float mx = -INFINITY, mx1 = -INFINITY;
#pragma unroll
                for (int i = 0; i < 16; ++i) { mx = fmaxf(mx, S0[i]); mx1 = fmaxf(mx1, S1[i]); }
                mx = fmaxf(mx, mx1 + b32) + base;
                mx = fmaxf(mx, __shfl_xor(mx, 32));
                {
                    const float mn = fmaxf(m, mx), alpha = fexp2(m - mn); m = mn; l *= alpha;
#pragma unroll
                    for (int d = 0; d < 4; ++d) O[d] = O[d] * alpha;
                }
                const float off = base - m, off1 = off + b32;
                float ps = 0.f;
#pragma unroll
                for (int i = 0; i < 16; ++i) { S0[i] = fexp2(S0[i] + off); S1[i] = fexp2(S1[i] + off1); ps += S0[i] + S1[i]; }
                l += ps;
                const bf16x8 p0 = pack8(S0, 0), p1 = pack8(S0, 1), p2 = pack8(S1, 0), p3 = pack8(S1, 1);
                __builtin_amdgcn_sched_barrier(0);
#pragma unroll
                for (int d = 0; d < 4; ++d) { O[d] = MFMA32(vf[d][0], p0, O[d]); O[d] = MFMA32(vf[d][1], p1, O[d]); }
                __builtin_amdgcn_sched_barrier(0);
#pragma unroll
                for (int d = 0; d < 4; ++d)
#pragma unroll
                    for (int s2 = 0; s2 < 2; ++s2) vf[d][s2] = *(const LAS bf16x8*)(buf + voff + d * 32 * DA_VP + (32 + 16 * s2) * 2);
#pragma unroll
                for (int d = 0; d < 4; ++d) { O[d] = MFMA32(vf[d][0], p2, O[d]); O[d] = MFMA32(vf[d][1], p3, O[d]); }
            }
            if (more) {
                LAS unsigned char* nb = lds + ((t + 1) & 1) * DA_BUF;
#pragma unroll
                for (int i = 0; i < 2; ++i) { *(LAS u32x4*)(nb + kst_off + i * 32 * DA_KP) = gk[i]; *(LAS u32x4*)(nb + vst_off + i * 64 * DA_VP) = gv[i]; } }
            __syncthreads();
        }
        for (int t = tmain; t < nkt; ++t) {
            const int key0 = t * 64;
            const bool more = (t + 1 < nkt);
            if (more) {
#pragma unroll
                for (int i = 0; i < 2; ++i) { gk[i] = *(const u32x4*)(kg + (size_t)(key0 + 64 + i * 32) * 2048); gv[i] = *(const u32x4*)(vg + (size_t)i * 64 * M_TOK + key0 + 64); } }
            LAS unsigned char* buf = lds + (t & 1) * DA_BUF;
            if (key0 <= q0 + 31) {
                f32x16 S0 = zero16(), S1 = zero16();
                {
                    bf16x8 kf[2][4];
#pragma unroll
                    for (int sub = 0; sub < 2; ++sub)
#pragma unroll
                        for (int ks = 0; ks < 4; ++ks) kf[sub][ks] = *(const LAS bf16x8*)(buf + koff + sub * 32 * DA_KP + ks * 32);
#pragma unroll
                    for (int ks = 0; ks < 4; ++ks) { const bf16x8 qfr = *(const LAS bf16x8*)(qlds + ks * 1024); S0 = MFMA32(kf[0][ks], qfr, S0); S1 = MFMA32(kf[1][ks], qfr, S1); }
                }
                __builtin_amdgcn_sched_barrier(0);
                bf16x8 vf[4][2];
#pragma unroll
                for (int d = 0; d < 4; ++d)
#pragma unroll
                    for (int s2 = 0; s2 < 2; ++s2) vf[d][s2] = *(const LAS bf16x8*)(buf + voff + d * 32 * DA_VP + (16 * s2) * 2);
                const float base = slope2 * (float)(key0 + 8 * hh - qpos), b32 = 32.f * slope2;
#pragma unroll
                for (int i = 0; i < 16; ++i) { S0[i] = S0[i] * c1 + cb[i]; S1[i] = S1[i] * c1 + cb[i]; }
                if (key0 + 63 > q0) {
                    const int kq = qpos - key0 - 8 * hh;
#pragma unroll
                    for (int i = 0; i < 16; ++i) { const int ko = (i & 7) + 16 * (i >> 3); S0[i] = (ko > kq) ? -INFINITY : S0[i]; S1[i] = (ko + 32 > kq) ? -INFINITY : S1[i]; }
                }
                float mx = -INFINITY, mx1 = -INFINITY;
#pragma unroll
                for (int i = 0; i < 16; ++i) { mx = fmaxf(mx, S0[i]); mx1 = fmaxf(mx1, S1[i]); }
                mx = fmaxf(mx, mx1 + b32) + base;
                mx = fmaxf(mx, __shfl_xor(mx, 32));
                {
                    const float mn = fmaxf(m, mx), alpha = fexp2(m - mn); m = mn; l *= alpha;
#pragma unroll
                    for (int d = 0; d < 4; ++d) O[d] = O[d] * alpha;
                }
                const float off = base - m, off1 = off + b32;
                float ps = 0.f;
#pragma unroll
                for (int i = 0; i < 16; ++i) { S0[i] = fexp2(S0[i] + off); S1[i] = fexp2(S1[i] + off1); ps += S0[i] + S1[i]; }
                l += ps;
                const bf16x8 p0 = pack8(S0, 0), p1 = pack8(S0, 1), p2 = pack8(S1, 0), p3 = pack8(S1, 1);
                __builtin_amdgcn_sched_barrier(0);
#pragma unroll
                for (int d = 0; d < 4; ++d) { O[d] = MFMA32(vf[d][0], p0, O[d]); O[d] = MFMA32(vf[d][1], p1, O[d]); }
                __builtin_amdgcn_sched_barrier(0);
#pragma unroll
                for (int d = 0; d < 4; ++d)
#pragma unroll
                    for (int s2 = 0; s2 < 2; ++s2) vf[d][s2] = *(const LAS bf16x8*)(buf + voff + d * 32 * DA_VP + (32 + 16 * s2) * 2);
#pragma unroll
                for (int d = 0; d < 4; ++d) { O[d] = MFMA32(vf[d][0], p2, O[d]); O[d] = MFMA32(vf[d][1], p3, O[d]); }
            }
            if (more) {
                LAS unsigned char* nb = lds + ((t + 1) & 1) * DA_BUF;
#pragma unroll
                for (int i = 0; i < 2; ++i) { *(LAS u32x4*)(nb + kst_off + i * 32 * DA_KP) = gk[i]; *(LAS u32x4*)(nb + vst_off + i * 64 * DA_VP) = gv[i]; } }
            __syncthreads();
        }
        const float lt = l + __shfl_xor(l, 32), inv = 1.f / lt;
        if (map == 1) { const float f = lam * inv;
#pragma unroll
            for (int d = 0; d < 4; ++d)
#pragma unroll
                for (int i = 0; i < 16; ++i) xch[((qsub * 4 + d) * 16 + i) * 64 + lane] = O[d][i] * f; }
        __syncthreads();
        if (map == 0) {
            float ss = 0.f;
#pragma unroll
            for (int d = 0; d < 4; ++d)
#pragma unroll
                for (int i = 0; i < 16; ++i) { const float o = O[d][i] * inv - xch[((qsub * 4 + d) * 16 + i) * 64 + lane]; O[d][i] = o; ss += o * o; }
            ss += __shfl_xor(ss, 32);
            const float rn = (1.f / sqrtf(ss * (1.f / 128.f) + 1e-6f)) * (1.f - lambda_init);
            bf16_t* orow = ob + (size_t)(b * SEQ + q0 + rr) * 1024 + hd * 128;
#pragma unroll
            for (int d = 0; d < 4; ++d)
#pragma unroll
                for (int gq = 0; gq < 4; ++gq) { const int dv0 = d * 32 + 8 * gq + 4 * hh; const f32x4 g4 = *(const f32x4*)(subg + dv0);
                    u32x2 w; w.x = pk2(O[d][4 * gq] * rn * g4.x, O[d][4 * gq + 1] * rn * g4.y); w.y = pk2(O[d][4 * gq + 2] * rn * g4.z, O[d][4 * gq + 3] * rn * g4.w);
                    *(u32x2*)(orow + dv0) = w; }
        }
        __syncthreads();
    }
}

DI void dil_attn_phase(int wv, const bf16_t* qk, const bf16_t* vt, float* oacc, float* stats, bf16_t* ob, int g, int dil) {
    const int tid = mk_tid(wv), wid = __builtin_amdgcn_readfirstlane(tid >> 6), lane = tid & 63, rr = lane & 31, hh = lane >> 5; const int bid = opaque_bid();
    const int L = SEQ / dil, ntl = L / 32; const int prr = (rr & 0x13) | ((rr & 4) << 1) | ((rr & 8) >> 1);
    const float c1 = 0.08838834764831845f * LOG2E;
    for (int task = bid * 8 + wid; task < 8192; task += gridDim.x * 8) {
        const int lt = task % ntl; int t2 = task / ntl; const int head = t2 & 7; t2 >>= 3; const int rph = t2 % dil, b = t2 / dil;
        const int l0 = lt * 32;
        const float slope2d = exp2f(-(float)(head + 1)) * LOG2E * (float)dil;
        const size_t qrow = (size_t)b * SEQ + (size_t)(l0 + rr) * dil + rph;
        bf16x8 qf[8];
#pragma unroll
        for (int ks = 0; ks < 8; ++ks) qf[ks] = *(const bf16x8*)(qk + qrow * 2048 + head * 128 + ks * 16 + hh * 8);
        f32x16 O[4];
#pragma unroll
        for (int d = 0; d < 4; ++d) O[d] = zero16();
        float m = -INFINITY, l = 0.f;
        for (int jt = 0; jt < 5; ++jt) {
            const int kl0 = l0 - 128 + 32 * jt;
            if (kl0 < 0) continue;
            const size_t krow = (size_t)b * SEQ + (size_t)(kl0 + prr) * dil + rph;
            bf16x8 kf[8];
#pragma unroll
            for (int ks = 0; ks < 8; ++ks) kf[ks] = *(const bf16x8*)(qk + krow * 2048 + 1024 + head * 128 + ks * 16 + hh * 8);
            const bf16_t* vb = vt + (size_t)(head * 128 + rr) * M_TOK + (size_t)b * SEQ + (size_t)rph * L + kl0 + 8 * hh;
            bf16x8 vf[4][2];
#pragma unroll
            for (int d = 0; d < 4; ++d)
#pragma unroll
                for (int s = 0; s < 2; ++s) vf[d][s] = *(const bf16x8*)(vb + (size_t)d * 32 * M_TOK + 16 * s);
            f32x16 S = zero16();
#pragma unroll
            for (int ks = 0; ks < 8; ++ks) S = MFMA32(kf[ks], qf[ks], S);
            float sv[16]; float mx = -INFINITY;
#pragma unroll
            for (int i = 0; i < 16; ++i) { const int dist = (l0 + rr) - (kl0 + (i & 7) + 16 * (i >> 3) + 8 * hh); float v = S[i] * c1 - slope2d * (float)dist; v = (dist >= 0 && dist <= 128) ? v : -INFINITY; sv[i] = v; mx = fmaxf(mx, v); }
            mx = fmaxf(mx, __shfl_xor(mx, 32));
            const float mn = fmaxf(m, mx), alpha = fexp2(m - mn); m = mn;
            float ps = 0.f; f32x16 P;
#pragma unroll
            for (int i = 0; i < 16; ++i) { const float pv = fexp2(sv[i] - mn); P[i] = pv; ps += pv; }
            l = l * alpha + ps;
#pragma unroll
            for (int d = 0; d < 4; ++d) O[d] = O[d] * alpha;
            const bf16x8 pf0 = pack8(P, 0), pf1 = pack8(P, 1);
#pragma unroll
            for (int d = 0; d < 4; ++d) { O[d] = MFMA32(vf[d][0], pf0, O[d]); O[d] = MFMA32(vf[d][1], pf1, O[d]); }
        }
        const float ltot = l + __shfl_xor(l, 32), inv = 1.f / ltot, lse2 = m + log2f(ltot);
        float* st = stats + (qrow * 8 + head) * 2;
        float a = 0.f, bw = 1.f, lrun = 1.f, mrun = lse2;
        if (g > 0) { const float m0 = st[0], lr0 = st[1]; const float mn = fmaxf(m0, lse2); a = fexp2(m0 - mn); bw = fexp2(lse2 - mn); lrun = lr0 * a + bw; mrun = mn; }
        float* orow = oacc + qrow * 1024 + head * 128;
        bf16_t* obrow = ob + qrow * 1024 + head * 128;
        const float f = inv * bw, il = 1.f / lrun;
#pragma unroll
        for (int d = 0; d < 4; ++d)
#pragma unroll
            for (int gq = 0; gq < 4; ++gq) { const int dv0 = d * 32 + 8 * gq + 4 * hh;
                f32x4 o = {O[d][4 * gq] * f, O[d][4 * gq + 1] * f, O[d][4 * gq + 2] * f, O[d][4 * gq + 3] * f};
                if (g > 0) { const f32x4 old = *(const f32x4*)(orow + dv0); o = o + old * a; }
                if (g < 2) *(f32x4*)(orow + dv0) = o;
                else { u32x2 w; w.x = pk2(o.x * il, o.y * il); w.y = pk2(o.z * il, o.w * il); *(u32x2*)(obrow + dv0) = w; } }
        if (g < 2 && hh == 0) { st[0] = mrun; st[1] = lrun; }
    }
}

DI float logsig(float z) { return fminf(z, 0.f) - __logf(1.f + __expf(-fabsf(z))); }
DI void gla_gate_phase(int wv, LAS unsigned char* lds, const float* x, const float* w_in, const float* w2, const float* bg, const bf16_t* qk1,
                       bf16_t* qd, bf16_t* ki, bf16_t* kst, float* decay, bf16_t* sbuf) {
    const int tid = mk_tid(wv), wid = tid >> 6, lane = tid & 63, rr = lane & 31, hh = lane >> 5; const int bid = opaque_bid();
    LAS float* wg = (LAS float*)lds;
    LAS float* gl = (LAS float*)(lds + 65536);
#pragma unroll
    for (int i = 0; i < 8; ++i) { const int idx = tid + 512 * i, k = idx >> 2, n4 = (idx & 3) * 4; *(LAS f32x4*)(wg + k * 16 + n4) = *(const f32x4*)(w_in + (size_t)k * 3088 + 3072 + n4); }
    __syncthreads();
    const int c = tid;
    float w2c[16];
#pragma unroll
    for (int j = 0; j < 16; ++j) w2c[j] = w2[j * 512 + c];
    const float bc = bg[c];
    for (int it = bid; it < 512; it += gridDim.x) {
        const int b = it >> 6, ch = it & 63; const size_t T0 = (size_t)b * SEQ + ch * 64;
        for (int tt = 0; tt < 8; tt += 2) {
            const size_t t0 = T0 + wid * 8 + tt;
            float a0[16], a1[16];
#pragma unroll
            for (int n = 0; n < 16; ++n) { a0[n] = 0.f; a1[n] = 0.f; }
#pragma unroll
            for (int i = 0; i < 16; ++i) { const int k = lane + 64 * i; const float x0 = x[t0 * DM + k], x1 = x[(t0 + 1) * DM + k];
#pragma unroll
                for (int q = 0; q < 4; ++q) { const f32x4 w = *(const LAS f32x4*)(wg + k * 16 + 4 * q);
                    a0[4 * q] += x0 * w.x; a0[4 * q + 1] += x0 * w.y; a0[4 * q + 2] += x0 * w.z; a0[4 * q + 3] += x0 * w.w;
                    a1[4 * q] += x1 * w.x; a1[4 * q + 1] += x1 * w.y; a1[4 * q + 2] += x1 * w.z; a1[4 * q + 3] += x1 * w.w; } }
            float v0 = 0.f, v1 = 0.f;
#pragma unroll
            for (int n = 0; n < 16; ++n) { const float s0 = wave_sum(a0[n]), s1 = wave_sum(a1[n]); v0 = (lane == n) ? s0 : v0; v1 = (lane == n) ? s1 : v1; }
            if (lane < 16) { gl[(wid * 8 + tt) * 16 + lane] = v0; gl[(wid * 8 + tt + 1) * 16 + lane] = v1; }
        }
        __syncthreads();
        float cum = 0.f;
#pragma unroll 4
        for (int t = 0; t < 64; ++t) { float z = bc;
#pragma unroll
            for (int q = 0; q < 4; ++q) { const f32x4 gv = *(const LAS f32x4*)(gl + t * 16 + 4 * q); z += gv.x * w2c[4 * q] + gv.y * w2c[4 * q + 1] + gv.z * w2c[4 * q + 2] + gv.w * w2c[4 * q + 3]; }
            cum += logsig(z) * 0.0625f; }
        const float blast = cum;
        decay[((size_t)b * 64 + ch) * 512 + c] = __expf(blast);
        cum = 0.f;
        for (int t8 = 0; t8 < 64; t8 += 8) {
            float ksv[8];
#pragma unroll
            for (int u = 0; u < 8; ++u) { const int t = t8 + u; float z = bc;
#pragma unroll
                for (int q = 0; q < 4; ++q) { const f32x4 gv = *(const LAS f32x4*)(gl + t * 16 + 4 * q); z += gv.x * w2c[4 * q] + gv.y * w2c[4 * q + 1] + gv.z * w2c[4 * q + 2] + gv.w * w2c[4 * q + 3]; }
                cum += logsig(z) * 0.0625f;
                const size_t tok = T0 + t;
                const float qv = bf2f(qk1[tok * 1024 + c]), kv = bf2f(qk1[tok * 1024 + 512 + c]);
                qd[tok * 512 + c] = f2bf(qv * 0.08838834764831845f * __expf(cum));
                ki[tok * 512 + c] = f2bf(kv * __expf(-cum));
                ksv[u] = kv * __expf(blast - cum); }
            u32x4 w; w.x = pk2(ksv[0], ksv[1]); w.y = pk2(ksv[2], ksv[3]); w.z = pk2(ksv[4], ksv[5]); w.w = pk2(ksv[6], ksv[7]);
            *(u32x4*)(kst + ((size_t)b * 512 + c) * SEQ + ch * 64 + t8) = w;
        }
        __syncthreads();
        const int hd = wid >> 1;
#pragma unroll
        for (int u = 0; u < 2; ++u) {
            const int tt2 = (wid & 1) * 2 + u, kt = tt2 >> 1, qt = tt2 & 1;
            f32x16 S = zero16();
            if (!(kt == 1 && qt == 0)) {
#pragma unroll
                for (int ks = 0; ks < 8; ++ks) { const bf16x8 A = *(const bf16x8*)(ki + (T0 + kt * 32 + rr) * 512 + hd * 128 + ks * 16 + hh * 8);
                    const bf16x8 B = *(const bf16x8*)(qd + (T0 + qt * 32 + rr) * 512 + hd * 128 + ks * 16 + hh * 8); S = MFMA32(A, B, S); } }
            const int q = qt * 32 + rr;
            bf16_t* srow = sbuf + (((size_t)b * 4 + hd) * 64 + ch) * 4096 + q * 64 + kt * 32;
#pragma unroll
            for (int gq = 0; gq < 4; ++gq) { const int k0 = 8 * gq + 4 * hh; float v[4];
#pragma unroll
                for (int e = 0; e < 4; ++e) v[e] = (kt * 32 + k0 + e <= q) ? S[4 * gq + e] : 0.f;
                u32x2 w; w.x = pk2(v[0], v[1]); w.y = pk2(v[2], v[3]); *(u32x2*)(srow + k0) = w; }
        }
    }
}
#define SCAN_BAR() do { asm volatile("s_waitcnt lgkmcnt(0)" ::: "memory"); __builtin_amdgcn_s_barrier(); asm volatile("" ::: "memory"); } while (0)
DI void gla_scan_phase(int wv, LAS unsigned char* lds, const bf16_t* qd, const bf16_t* kst, const bf16_t* sbuf, const bf16_t* vt, const float* decay, float* obuf) {
    const int tid = mk_tid(wv), wid = __builtin_amdgcn_readfirstlane(tid >> 6), lane = tid & 63, rr = lane & 31, hh = lane >> 5; const int bid = opaque_bid();
    LAS float* red = (LAS float*)lds;
    for (int task = bid; task < 256; task += gridDim.x) {
        const int dvs = task & 7, hd = (task >> 3) & 3, b = task >> 5;
        const bf16_t* vrow = vt + (size_t)(hd * 256 + dvs * 32) * M_TOK + (size_t)b * SEQ; const unsigned lv = (unsigned)(rr * M_TOK + 8 * hh);
        if (wid < 4) {
            const int kb = wid;
            f32x16 St = zero16();
            const bf16_t* krow = kst + ((size_t)b * 512 + hd * 128 + kb * 32) * SEQ; const unsigned lk = (unsigned)(rr * SEQ + 8 * hh);
            const bf16_t* qp0 = qd + (size_t)b * SEQ * 512 + hd * 128 + kb * 32; const unsigned lq = (unsigned)(rr * 512 + 4 * hh);
            const float* dp0 = decay + (size_t)b * 64 * 512 + hd * 128 + kb * 32; const unsigned ld_ = (unsigned)(4 * hh);
            const int qt = wid >> 1;
            bf16x8 vA[4], kA[4], qB[4]; f32x4 dc[4];
            bf16x8 nvA[4], nkA[4], nqB[4]; f32x4 ndc[4];
#define SCAN_LOADC(c_, vA_, kA_, qB_, dc_) do { \
            _Pragma("unroll") for (int ks = 0; ks < 4; ++ks) { vA_[ks] = *(const bf16x8*)(vrow + (lv + (unsigned)((c_) * 64 + 16 * ks))); kA_[ks] = *(const bf16x8*)(krow + (lk + (unsigned)((c_) * 64 + 16 * ks))); } \
            _Pragma("unroll") for (int s_ = 0; s_ < 2; ++s_) _Pragma("unroll") for (int q_ = 0; q_ < 2; ++q_) { const bf16_t* qp = qp0 + (lq + (unsigned)(((c_) * 64 + q_ * 32) * 512 + 16 * s_)); \
                qB_[2 * s_ + q_] = cat44(*(const s16x4*)qp, *(const s16x4*)(qp + 8)); } \
            _Pragma("unroll") for (int gq = 0; gq < 4; ++gq) dc_[gq] = *(const f32x4*)(dp0 + (ld_ + (unsigned)((c_) * 512 + 8 * gq))); } while (0)
#define SCAN_BODYC(c, vA, kA, qB, dc, nvA, nkA, nqB, ndc) do { \
            const int cn = (c) < 63 ? (c) + 1 : 63; \
            SCAN_LOADC(cn, nvA, nkA, nqB, ndc); \
            LAS float* rb = red + ((c) & 1) * (5 * 2 * 16 * 64); \
            { f32x16 O0 = zero16(), O1 = zero16(); \
              _Pragma("unroll") for (int s_ = 0; s_ < 2; ++s_) { const bf16x8 stA = pack8(St, s_); O0 = MFMA32(stA, qB[2 * s_], O0); O1 = MFMA32(stA, qB[2 * s_ + 1], O1); } \
              LAS float* wp = rb + (wid * 2 * 16) * 64 + lane; \
              _Pragma("unroll") for (int i = 0; i < 16; ++i) { wp[i * 64] = O0[i]; wp[(16 + i) * 64] = O1[i]; } } \
            _Pragma("unroll") for (int gq = 0; gq < 4; ++gq) { St[4 * gq] *= dc[gq].x; St[4 * gq + 1] *= dc[gq].y; St[4 * gq + 2] *= dc[gq].z; St[4 * gq + 3] *= dc[gq].w; } \
            _Pragma("unroll") for (int ks = 0; ks < 4; ++ks) St = MFMA32(kA[ks], vA[ks], St); \
            SCAN_BAR(); \
            { const size_t T0 = (size_t)b * SEQ + (c) * 64; \
              _Pragma("unroll") for (int g2 = 0; g2 < 2; ++g2) { const int gq = 2 * (wid & 1) + g2; f32x4 acc = {0.f, 0.f, 0.f, 0.f}; \
                _Pragma("unroll") for (int sl = 0; sl < 5; ++sl) \
                    _Pragma("unroll") for (int e = 0; e < 4; ++e) acc[e] += rb[((sl * 2 + qt) * 16 + 4 * gq + e) * 64 + lane]; \
                *(f32x4*)(obuf + (T0 + qt * 32 + rr) * 1024 + hd * 256 + dvs * 32 + 8 * gq + 4 * hh) = acc; } } } while (0)
            SCAN_LOADC(0, vA, kA, qB, dc);
#pragma nounroll
            for (int c = 0; c < 64; c += 2) {
                SCAN_BODYC(c, vA, kA, qB, dc, nvA, nkA, nqB, ndc);
                SCAN_BODYC(c + 1, nvA, nkA, nqB, ndc, vA, kA, qB, dc);
            }
#undef SCAN_BODYC
#undef SCAN_LOADC
        } else if (wid == 4) {
            const bf16_t* sb0 = sbuf + ((size_t)b * 4 + hd) * 64 * 4096; const unsigned ls = (unsigned)(rr * 64 + 8 * hh);
            bf16x8 vA[4], sB[6], nvA[4], nsB[6];
#define SCAN_LOADI(c_, vA_, sB_) do { \
            _Pragma("unroll") for (int ks = 0; ks < 4; ++ks) vA_[ks] = *(const bf16x8*)(vrow + (lv + (unsigned)((c_) * 64 + 16 * ks))); \
            _Pragma("unroll") for (int ks = 0; ks < 2; ++ks) sB_[ks] = *(const bf16x8*)(sb0 + (ls + (unsigned)((c_) * 4096 + 16 * ks))); \
            _Pragma("unroll") for (int ks = 0; ks < 4; ++ks) sB_[2 + ks] = *(const bf16x8*)(sb0 + (ls + (unsigned)((c_) * 4096 + 32 * 64 + 16 * ks))); } while (0)
#define SCAN_BODYI(c, vA, sB, nvA, nsB) do { \
            const int cn = (c) < 63 ? (c) + 1 : 63; \
            SCAN_LOADI(cn, nvA, nsB); \
            LAS float* rb = red + ((c) & 1) * (5 * 2 * 16 * 64); \
            f32x16 O0 = zero16(), O1 = zero16(); \
            O0 = MFMA32(vA[0], sB[0], O0); O0 = MFMA32(vA[1], sB[1], O0); \
            _Pragma("unroll") for (int ks = 0; ks < 4; ++ks) O1 = MFMA32(vA[ks], sB[2 + ks], O1); \
            LAS float* wp = rb + (4 * 2 * 16) * 64 + lane; \
            _Pragma("unroll") for (int i = 0; i < 16; ++i) { wp[i * 64] = O0[i]; wp[(16 + i) * 64] = O1[i]; } \
            SCAN_BAR(); } while (0)
            SCAN_LOADI(0, vA, sB);
#pragma nounroll
            for (int c = 0; c < 64; c += 2) {
                SCAN_BODYI(c, vA, sB, nvA, nsB);
                SCAN_BODYI(c + 1, nvA, nsB, vA, sB);
            }
#undef SCAN_BODYI
#undef SCAN_LOADI
        } else {
#pragma nounroll
            for (int c = 0; c < 64; ++c) SCAN_BAR();
        }
        __syncthreads();
    }
}
#undef SCAN_BAR
DI void gla_finish_phase(int wv, const float* obuf, const bf16_t* rb, const float* gn, bf16_t* ob) {
    const int tid = mk_tid(wv), wid = tid >> 6, lane = tid & 63; const int bid = opaque_bid();
    const f32x4 g4 = ((const f32x4*)gn)[lane];
    const int nw = gridDim.x * 8;
    for (int row0 = bid * 8 + wid; row0 < M_TOK; row0 += 2 * nw) {
        f32x4 v[2][4]; u32x2 rw[2][4];
#pragma unroll
        for (int u = 0; u < 2; ++u) { const int row = (row0 + u * nw < M_TOK) ? row0 + u * nw : row0;
#pragma unroll
            for (int i = 0; i < 4; ++i) { v[u][i] = ((const f32x4*)(obuf + (size_t)row * 1024))[lane + 64 * i]; rw[u][i] = ((const u32x2*)(rb + (size_t)row * 1024))[lane + 64 * i]; } }
#pragma unroll
        for (int u = 0; u < 2; ++u) { const int row = row0 + u * nw; if (row < M_TOK) {
#pragma unroll
            for (int i = 0; i < 4; ++i) {
                const f32x4 x = v[u][i];
                const float ss = wave_sum((x.x * x.x + x.y * x.y) + (x.z * x.z + x.w * x.w));
                const float rn = 1.f / sqrtf(ss * (1.f / 256.f) + 1e-6f);
                const u32x2 r_ = rw[u][i];
                const float r0 = __uint_as_float(r_.x << 16), r1 = __uint_as_float(r_.x & 0xffff0000u), r2 = __uint_as_float(r_.y << 16), r3 = __uint_as_float(r_.y & 0xffff0000u);
                const float s0 = r0 / (1.f + expf(-r0)), s1 = r1 / (1.f + expf(-r1)), s2 = r2 / (1.f + expf(-r2)), s3 = r3 / (1.f + expf(-r3));
                u32x2 w; w.x = pk2(x.x * rn * g4.x * s0, x.y * rn * g4.y * s1); w.y = pk2(x.z * rn * g4.z * s2, x.w * rn * g4.w * s3);
                ((u32x2*)(ob + (size_t)row * 1024))[lane + 64 * i] = w;
            } } }
    }
}

DI unsigned xcc_id() { return (unsigned)__builtin_amdgcn_s_getreg((3 << 11) | 20) & 0xFu; }
DI void grid_barrier(int wv, unsigned* bar_, unsigned k, LAS unsigned* stash) {
    unsigned* bar = bar_ + opq_off(0);
    asm volatile("s_waitcnt vmcnt(0) lgkmcnt(0)" ::: "memory");
    __syncthreads();
    if (mk_tid(wv) == 0) {
        const unsigned xcc = xcc_id(), nx = stash[0], nxcc = stash[1];
        const unsigned old = __hip_atomic_fetch_add(bar + 64 * (17 + xcc), 1u, __ATOMIC_RELAXED, __HIP_MEMORY_SCOPE_AGENT);
        if (old == k * nx - 1u) {
            __builtin_amdgcn_fence(__ATOMIC_RELEASE, "agent");
            asm volatile("s_waitcnt vmcnt(0)" ::: "memory");
            const unsigned old2 = __hip_atomic_fetch_add(bar + 64 * 33, 1u, __ATOMIC_RELAXED, __HIP_MEMORY_SCOPE_AGENT);
            if (old2 == k * nxcc - 1u) __hip_atomic_store(bar + 64 * 34, k, __ATOMIC_RELAXED, __HIP_MEMORY_SCOPE_AGENT);
        }
        while (__hip_atomic_load(bar + 64 * 34, __ATOMIC_RELAXED, __HIP_MEMORY_SCOPE_AGENT) < k) __builtin_amdgcn_s_sleep(2);
        __builtin_amdgcn_fence(__ATOMIC_ACQUIRE, "agent");
        asm volatile("s_waitcnt vmcnt(0)" ::: "memory");
    }
    __syncthreads();
}

__global__ void __launch_bounds__(512) mega(Params p) {
    extern __shared__ __attribute__((aligned(16))) unsigned char shm[];
    LAS unsigned char* lds = (LAS unsigned char*)shm;
    cg::grid_group grid = cg::this_grid();
    const int wv = __builtin_amdgcn_readfirstlane((int)threadIdx.x >> 6);
    int ph = 0; unsigned nbar = 0;
    LAS unsigned* stash = (LAS unsigned*)(lds + LDS_PHASE_BYTES);
#define xb ((bf16_t*)(p.ws + opq_off(XB_OFF)))
#define wb ((bf16_t*)(p.ws + opq_off(WB_OFF)))
#define scr (p.ws + opq_off(SCR_OFF))
#define barctr ((unsigned*)(p.ws + opq_off(BAR_OFF)))
#define STT ((float*)(p.ws + opq_off(BAR_OFF + 65536)))
    float* X = p.out;
    if (mk_tid(wv) == 0) __hip_atomic_fetch_add(barctr + 64 * (1 + xcc_id()), 1u, __ATOMIC_RELAXED, __HIP_MEMORY_SCOPE_AGENT);
#define PH_BEGIN if (ph >= p.ph_lo && ph < p.ph_hi) {
#define PH_END   if (ph + 1 < p.ph_hi) { if (ph == p.ph_lo) { grid.sync(); \
        if (mk_tid(wv) == 0) { unsigned nx_ = __hip_atomic_load(barctr + 64 * (1 + xcc_id()), __ATOMIC_RELAXED, __HIP_MEMORY_SCOPE_AGENT), nxcc_ = 0; \
            for (int x_ = 0; x_ < 16; ++x_) nxcc_ += __hip_atomic_load(barctr + 64 * (1 + x_), __ATOMIC_RELAXED, __HIP_MEMORY_SCOPE_AGENT) != 0u ? 1u : 0u; \
            stash[0] = nx_; stash[1] = nxcc_; } } \
        else { ++nbar; grid_barrier(wv, barctr, nbar, stash); } } } ++ph;
    PH_BEGIN
        xconvert(wv, p.in[0], xb);
        wprep_layer(wv, lds, p, 0, wb);
    PH_END
#pragma nounroll
    for (int layer = 0; layer < 4; ++layer) {
        const int kind = layer % 3, ib = layer_base(layer), wo = wout_idx(layer);
        const int nin = kind == 1 ? 9216 : 3072;
        bf16_t* wb_out = wb + (size_t)nin * 1024; bf16_t* wb_1 = wb_out + 1024 * 1024; bf16_t* wb_2 = wb_1 + 4096 * 1024;
        bf16_t* QK = (bf16_t*)scr;
        bf16_t* VT = (bf16_t*)(scr + (kind == 2 ? 192 : 128) * MiB);
        bf16_t* OB = (bf16_t*)(scr + 192 * MiB);
        float* OACC = (float*)(scr + 256 * MiB); float* STATS = (float*)(scr + 384 * MiB);
        bf16_t* KI = (bf16_t*)(scr + 64 * MiB); float* OBUF = (float*)scr; bf16_t* RB = (bf16_t*)(scr + 128 * MiB);
        bf16_t* QD = (bf16_t*)(scr + 256 * MiB); bf16_t* KST = (bf16_t*)(scr + 288 * MiB); bf16_t* SB = (bf16_t*)(scr + 320 * MiB); float* DEC = (float*)(scr + 336 * MiB);
        bf16_t* H = (bf16_t*)scr;
        const int ng = kind == 1 ? 3 : 1;
#pragma nounroll
        for (int g = 0; g < ng; ++g) {
            const int dil = kind == 1 ? (g == 0 ? 1 : g == 1 ? 4 : 16) : 1;
            PH_BEGIN
                const int ngemm = kind == 2 ? 3 : 2;
#pragma nounroll
                for (int rep = 0; rep < REP_MIXG; ++rep)
#pragma nounroll
                for (int gi = 0; gi < ngemm; ++gi) {
                    GemmD d; EpiBf16<0> E;
                    d.K = 1024; d.dil = 1; d.L = 4096;
                    const bf16_t* wg_ = wb + (size_t)g * 3072 * 1024;
                    const bool isvt = (gi == ngemm - 1);
                    if (!isvt) {
                        d.A = xb; d.lda = 1024; d.ldb = 1024; d.nM = 128;
                        if (kind == 2) { d.Bt = wg_ + (size_t)(gi == 0 ? 0 : 2048) * 1024; d.nN = 4; E.O = gi == 0 ? QK : RB; E.ldc = 1024; }
                        else { d.Bt = wg_; d.nN = 8; E.O = QK; E.ldc = 2048; }
                    } else {
                        d.A = wg_ + (size_t)(kind == 2 ? 1024 : 2048) * 1024; d.lda = 1024; d.nM = 4;
                        d.Bt = xb; d.ldb = 1024; d.nN = 128; d.dil = dil; d.L = 4096 / dil; E.O = VT; E.ldc = M_TOK;
                    }
                    gemm_phase(wv, lds, d, E);
                }
            PH_END
            if (kind == 0) {
                PH_BEGIN
                    for (int rep = 0; rep < REP_DIFF; ++rep) diff_attn_phase(wv, lds, QK, VT, OB, p.in[ib + 1], p.in[ib + 2], p.in[ib + 3], p.in[ib + 4], p.in[ib + 5], layer);
                PH_END
            } else if (kind == 1) {
                PH_BEGIN
                    for (int rep = 0; rep < (g == 0 ? REP_DIL0 : 1); ++rep) { if (rep) __syncthreads(); dil_attn_phase(wv, QK, VT, OACC, STATS, OB, g, dil); }
                PH_END
            } else {
                PH_BEGIN
                    for (int rep = 0; rep < REP_GATE; ++rep) { if (rep) __syncthreads(); gla_gate_phase(wv, lds, X, p.in[ib], p.in[ib + 1], p.in[ib + 2], QK, QD, KI, KST, DEC, SB); }
                PH_END
                PH_BEGIN
                    for (int rep = 0; rep < REP_SCAN; ++rep) gla_scan_phase(wv, lds, QD, KST, SB, VT, DEC, OBUF);
                PH_END
                PH_BEGIN
                    gla_finish_phase(wv, OBUF, RB, p.in[ib + 3], OB);
                PH_END
            }
        }
#pragma nounroll
        for (int sub = 0; sub < 2; ++sub) {
            if (sub == 1) {
                PH_BEGIN
                    GemmD d; EpiBf16<1> E;
                    d.A = xb; d.lda = 1024; d.Bt = wb_1; d.ldb = 1024; d.K = 1024; d.nM = 128; d.nN = 16; d.dil = 1; d.L = 4096; E.O = H; E.ldc = 4096;
#pragma nounroll
                    for (int rep = 0; rep < REP_FFN1; ++rep) gemm_phase(wv, lds, d, E);
                PH_END
            }
            PH_BEGIN
                GemmD d; EpiBf16<0> E;
                d.A = sub == 0 ? OB : H; d.lda = sub == 0 ? 1024 : 4096; d.Bt = sub == 0 ? wb_out : wb_2; d.ldb = d.lda; d.K = d.lda; d.nM = 128; d.nN = 4; d.dil = 1; d.L = 4096;
                E.O = (bf16_t*)(scr + 256 * MiB); E.ldc = 1024;
                gemm_phase(wv, lds, d, E);
            PH_END
            PH_BEGIN
                ln_phase(wv, (const bf16_t*)(scr + 256 * MiB), ((layer == 3 || layer == 1) && sub == 1) ? X : nullptr, p.in[wo + 1 + 4 * sub], p.in[wo + 2 + 4 * sub], xb);
                if (sub == 1 && layer < 3) for (int rep = 0; rep < REP_PREP; ++rep) { if (rep) __syncthreads(); wprep_layer(wv, lds, p, layer + 1, wb); }
            PH_END
        }
    }
}

#undef xb
#undef wb
#undef scr
#undef barctr
#undef STT
extern "C" void kernel_launch(void* const* d_in, const int* in_sizes, int n_in, void* d_out, int out_size, void* d_ws, size_t ws_size, hipStream_t stream) {
    static int grid = 0;
    if (grid == 0) {
        if (n_in != 46 || ws_size < WS_NEED) { fprintf(stderr, "kernel_launch: unexpected n_in %d or ws_size %zu\n", n_in, ws_size); grid = -1; return; }
        int dev = 0, cus = 0, per_cu = 0;
        hipGetDevice(&dev);
        hipDeviceGetAttribute(&cus, hipDeviceAttributeMultiprocessorCount, dev);
        hipFuncSetAttribute((const void*)mega, hipFuncAttributeMaxDynamicSharedMemorySize, LDS_BYTES);
        hipOccupancyMaxActiveBlocksPerMultiprocessor(&per_cu, (const void*)mega, 512, LDS_BYTES);
        if (per_cu < 1) { fprintf(stderr, "kernel_launch: occupancy query says %d blocks per CU\n", per_cu); per_cu = 1; }
        (void)hipGetLastError();
        grid = cus * per_cu;
    }
    if (grid < 0) return;
    Params p{};
    for (int i = 0; i < 46; ++i) p.in[i] = (const float*)d_in[i];
    p.out = (float*)d_out; p.ws = (unsigned char*)d_ws;
#if MULTI_LAUNCH
    for (int ph = 0; ph < NPH; ++ph) { p.ph_lo = ph; p.ph_hi = ph + 1; hipLaunchKernelGGL(mega, dim3(grid), dim3(512), LDS_BYTES, stream, p); }
#else
    p.ph_lo = 0; p.ph_hi = NPH;
    (void)hipMemsetAsync((unsigned char*)d_ws + BAR_OFF, 0, 16384, stream);
    void* args[] = {&p};
    hipError_t e = hipLaunchCooperativeKernel((const void*)mega, dim3(grid), dim3(512), args, LDS_BYTES, stream);
    if (e != hipSuccess) fprintf(stderr, "cooperative launch failed: %s (grid %d)\n", hipGetErrorString(e), grid);
#endif
}
```

```cpp
#include <hip/hip_runtime.h>
#include <hip/hip_cooperative_groups.h>
#include <cstdio>
namespace cg = cooperative_groups;

#ifndef MULTI_LAUNCH
#define MULTI_LAUNCH 0
#endif

#define REP_MIXG 1
#define REP_FFN1 1
#define REP_DIL0 1
#define REP_GATE 1
#define REP_SCAN 1
#define REP_DIFF 1
#define REP_PREP 1
#define DI __device__ __forceinline__
#define LAS __attribute__((address_space(3)))
typedef unsigned short bf16_t;
typedef short bf16x8 __attribute__((ext_vector_type(8)));
typedef short s16x4 __attribute__((ext_vector_type(4)));
typedef float f32x2 __attribute__((ext_vector_type(2)));
typedef float f32x4 __attribute__((ext_vector_type(4)));
typedef float f32x16 __attribute__((ext_vector_type(16)));
typedef unsigned u32x2 __attribute__((ext_vector_type(2)));
typedef unsigned u32x4 __attribute__((ext_vector_type(4)));
typedef __bf16 bf2_t __attribute__((ext_vector_type(2)));

constexpr int M_TOK = 32768, DM = 1024, SEQ = 4096, NPH = 35;
constexpr float LOG2E = 1.4426950408889634f;
constexpr float ALPHA_RES = 1.681792830507429f;
constexpr size_t MiB = 1024 * 1024;
constexpr size_t XB_OFF = 0, WB_OFF = 64 * MiB, SCR_OFF = 104 * MiB, BAR_OFF = 491 * MiB, WS_NEED = 492 * MiB;
constexpr int LDS_PHASE_BYTES = 131072, LDS_BYTES = LDS_PHASE_BYTES + 256;

struct Params {
    const float* in[46];
    float* out;
    unsigned char* ws;
    int ph_lo, ph_hi;
};

DI unsigned pk2(float lo, float hi) { f32x2 f = {lo, hi}; bf2_t v = __builtin_convertvector(f, bf2_t); return __builtin_bit_cast(unsigned, v); }
DI bf16_t f2bf(float x) { return (bf16_t)(pk2(x, 0.f) & 0xffffu); }
DI float bf2f(bf16_t v) { return __uint_as_float(((unsigned)v) << 16); }
DI float wave_sum(float v) {
#pragma unroll
    for (int o = 1; o < 64; o <<= 1) v += __shfl_xor(v, o);
    return v;
}
DI int mk_tid(int wv) { int w = wv; asm volatile("" : "+s"(w)); int l = __builtin_amdgcn_mbcnt_hi(~0u, __builtin_amdgcn_mbcnt_lo(~0u, 0u)); asm volatile("" : "+v"(l)); return w * 64 + l; }
DI size_t opq_off(size_t o) { asm volatile("" : "+s"(o)); return o; }
DI int opaque_bid() { int b = blockIdx.x; asm volatile("" : "+s"(b)); return b; }
DI float fexp2(float x) { return __builtin_amdgcn_exp2f(x); }
DI int crow(int i, int hh) { return (i & 3) + 8 * (i >> 2) + 4 * hh; }
#define MFMA32(a, b, c) __builtin_amdgcn_mfma_f32_32x32x16_bf16((a), (b), (c), 0, 0, 0)
DI bf16x8 cat44(s16x4 lo, s16x4 hi) { return __builtin_shufflevector(lo, hi, 0, 1, 2, 3, 4, 5, 6, 7); }
DI bf16x8 pack8(const f32x16& x, int s) {
    u32x4 w;
    w.x = pk2(x[8 * s + 0], x[8 * s + 1]); w.y = pk2(x[8 * s + 2], x[8 * s + 3]);
    w.z = pk2(x[8 * s + 4], x[8 * s + 5]); w.w = pk2(x[8 * s + 6], x[8 * s + 7]);
    return __builtin_bit_cast(bf16x8, w);
}
DI f32x16 zero16() { f32x16 z; for (int i = 0; i < 16; ++i) z[i] = 0.f; return z; }

constexpr int BM = 256, BK = 64, HALF = 128, HTB = HALF * BK * 2, NXCD = 8, WGM = 8;
DI int lds_byte(int r, int c) { const int st = (r >> 4) * 2 + (c >> 5), rr = r & 15, cc = c & 31, ob = rr * 64 + cc * 2; return st * 1024 + (ob ^ (((ob >> 9) & 1) << 5)); }
DI void stage_rc(int b, int& R, int& C) { const int st = b / 1024, sb = b % 1024, swz = sb ^ (((sb >> 9) & 1) << 5); R = (st >> 1) * 16 + swz / 64; C = (st & 1) * 32 + (swz % 64) / 2; }
DI int perm32(int rho) { const int n = rho >> 4, i = rho & 15; return 8 * (i >> 2) + 4 * n + (i & 3); }

struct Unit { int pm, pn; };
struct GemmD { const bf16_t* A; const bf16_t* Bt; int lda, ldb, K, nM, nN, dil, L; };
struct StaticOrder {
    int nM, nN, nwg, G, c;
    DI void init(int nM_, int nN_, int G_, int c_) { nM = nM_; nN = nN_; nwg = nM * nN; G = G_; c = c_; }
    DI bool next(int i, Unit& u) const {
        const long Lx = (long)i * G + c; if (Lx >= nwg) return false;
        int wgid = (int)Lx; { const int q = nwg / NXCD, r = nwg % NXCD, xcd = wgid % NXCD, off = wgid / NXCD; wgid = (xcd < r ? xcd * (q + 1) : r * (q + 1) + (xcd - r) * q) + off; }
        const int nig = WGM * nN, gid = wgid / nig, fm = gid * WGM, gsz = (nM - fm) < WGM ? (nM - fm) : WGM;
        u.pm = fm + ((wgid % nig) % gsz); u.pn = (wgid % nig) / gsz; return true;
    }
};

template <int ACT  > struct EpiBf16 {
    static constexpr bool PERM = true;
    bf16_t* O; size_t ldc;
    DI void operator()(const f32x4 (&acc)[2][2][4][2], const Unit& u, int wr, int wc, int fr, int fq) const {
        const int row0 = u.pm * BM + wr * 64 + fr; const int col0 = u.pn * BM + wc * 32 + 8 * fq;
#pragma unroll
        for (int ai = 0; ai < 2; ++ai)
#pragma unroll
            for (int m = 0; m < 4; ++m) { bf16_t* rowp = O + (size_t)(row0 + ai * HALF + m * 16) * ldc + col0;
#pragma unroll
                for (int bj = 0; bj < 2; ++bj) { f32x4 v0 = acc[ai][bj][m][0], v1 = acc[ai][bj][m][1];
                    if (ACT == 1) {
#pragma unroll
                        for (int j = 0; j < 4; ++j) { float a = fmaxf(v0[j], 0.f), b = fmaxf(v1[j], 0.f); v0[j] = a * a; v1[j] = b * b; } }
                    u32x4 w; w.x = pk2(v0[0], v0[1]); w.y = pk2(v0[2], v0[3]); w.z = pk2(v1[0], v1[1]); w.w = pk2(v1[2], v1[3]);
                    *(u32x4*)(rowp + bj * HALF) = w; } }
    }
};
struct EpiRes {
    static constexpr bool PERM = true;
    const bf16_t* res; bf16_t* out;
    DI void operator()(const f32x4 (&acc)[2][2][4][2], const Unit& u, int wr, int wc, int fr, int fq) const {
        const int row0 = u.pm * BM + wr * 64 + fr, col0 = u.pn * BM + wc * 32 + 8 * fq;
#pragma unroll
        for (int ai = 0; ai < 2; ++ai)
#pragma unroll
            for (int m = 0; m < 4; ++m) { const size_t ro = (size_t)(row0 + ai * HALF + m * 16) * DM + col0;
#pragma unroll
                for (int bj = 0; bj < 2; ++bj) { const u32x4 r = *(const u32x4*)(res + ro + bj * HALF);
                    const f32x4 v0 = acc[ai][bj][m][0], v1 = acc[ai][bj][m][1];
                    u32x4 w;
                    w.x = pk2(__uint_as_float(r.x << 16) * ALPHA_RES + v0[0], __uint_as_float(r.x & 0xffff0000u) * ALPHA_RES + v0[1]);
                    w.y = pk2(__uint_as_float(r.y << 16) * ALPHA_RES + v0[2], __uint_as_float(r.y & 0xffff0000u) * ALPHA_RES + v0[3]);
                    w.z = pk2(__uint_as_float(r.z << 16) * ALPHA_RES + v1[0], __uint_as_float(r.z & 0xffff0000u) * ALPHA_RES + v1[1]);
                    w.w = pk2(__uint_as_float(r.w << 16) * ALPHA_RES + v1[2], __uint_as_float(r.w & 0xffff0000u) * ALPHA_RES + v1[3]);
                    *(u32x4*)(out + ro + bj * HALF) = w; } }
    }
};

template <class Epi>
DI void gemm_phase(int wv, LAS unsigned char* lds, const GemmD g, const Epi& E) {
    const int tid = mk_tid(wv), wid = __builtin_amdgcn_readfirstlane(tid >> 6), lane = tid & 63, wr = wid >> 2, wc = wid & 3, fr = lane & 15, fq = lane >> 4;
    const int K = g.K, nt = K / BK;
    const int ldbe = g.ldb * g.dil;
    unsigned voffA[2], voffB[2];
#pragma unroll
    for (int i = 0; i < 2; ++i) { int R, C; stage_rc(tid * 16 + i * 8192, R, C); const int Rb = Epi::PERM ? ((R & ~31) + perm32(R & 31)) : R;
        voffA[i] = (unsigned)(R * g.lda + C) * 2u; voffB[i] = (unsigned)(Rb * ldbe + C) * 2u; }
    const size_t kstep = (size_t)(BK * 2);
    const size_t hstepA = (size_t)HALF * g.lda * 2, hstepB = (size_t)HALF * ldbe * 2;
    const unsigned ldsw = (unsigned)wid * 1024u;
    const int aoff = lds_byte(wr * 64 + fr, fq * 8), boff = lds_byte(wc * 32 + fr, fq * 8);
#define PG8_SA(b, h) (((b) * 2 + (h)) * HTB)
#define PG8_SB(b, h) ((4 + (b) * 2 + (h)) * HTB)
#define PG8_STAGE(bufoff, gbase, voff) do { _Pragma("unroll") for (int _i = 0; _i < 2; ++_i) \
        __builtin_amdgcn_global_load_lds((const unsigned*)((const char*)(gbase) + (voff)[_i]), (LAS unsigned*)(lds + (bufoff) + ldsw + _i * 8192), 16, 0, 0); } while (0)
#define PG8_LDA(dst, b, h) do { _Pragma("unroll") for (int m = 0; m < 4; ++m) _Pragma("unroll") for (int k = 0; k < 2; ++k) dst[m][k] = *(const LAS bf16x8*)(lds + PG8_SA(b, h) + aoff + m * 2048 + k * 1024); } while (0)
#define PG8_LDB(dst, b, h) do { _Pragma("unroll") for (int n = 0; n < 2; ++n) _Pragma("unroll") for (int k = 0; k < 2; ++k) dst[n][k] = *(const LAS bf16x8*)(lds + PG8_SB(b, h) + boff + n * 2048 + k * 1024); } while (0)
#define PG8_MMA(ai, bj, At, Bt) do { __builtin_amdgcn_s_setprio(1); _Pragma("unroll") for (int m = 0; m < 4; ++m) _Pragma("unroll") for (int n = 0; n < 2; ++n) _Pragma("unroll") for (int k = 0; k < 2; ++k) \
        acc[ai][bj][m][n] = __builtin_amdgcn_mfma_f32_16x16x32_bf16(Bt[n][k], At[m][k], acc[ai][bj][m][n], 0, 0, 0); __builtin_amdgcn_s_setprio(0); } while (0)
#define PG8_WAIT_V(n) asm volatile("s_waitcnt vmcnt(" #n ")" ::: "memory")
#define PG8_WAIT_L(n) asm volatile("s_waitcnt lgkmcnt(" #n ")" ::: "memory")
#define PG8_BAR __builtin_amdgcn_s_barrier()
#define PG8_SCHED __builtin_amdgcn_sched_barrier(0)
    StaticOrder S; S.init(g.nM, g.nN, (int)gridDim.x, opaque_bid());
    Unit cur, nxt; int ui = 0;
    if (!S.next(0, cur)) return;
    f32x4 acc[2][2][4][2];
#pragma unroll
    for (int a = 0; a < 2; ++a)
#pragma unroll
        for (int b = 0; b < 2; ++b)
#pragma unroll
            for (int m = 0; m < 4; ++m)
#pragma unroll
                for (int n = 0; n < 2; ++n) acc[a][b][m][n] = (f32x4){0.f, 0.f, 0.f, 0.f};
    bf16x8 At[4][2], B0[2][2], B1[2][2];
#define PG8_BROW(pn_) ({ const int p0_ = (pn_) * 256; const int bb_ = p0_ >> 12, rem_ = p0_ & 4095, r_ = rem_ / g.L, l0_ = rem_ - r_ * g.L; (size_t)(bb_ * 4096 + l0_ * g.dil + r_); })
    const char* cA = (const char*)g.A + (size_t)cur.pm * 256 * g.lda * 2; const char* cB = (const char*)g.Bt + PG8_BROW(cur.pn) * (size_t)g.ldb * 2;
    PG8_STAGE(PG8_SB(0, 0), cB, voffB); PG8_STAGE(PG8_SA(0, 0), cA, voffA); PG8_STAGE(PG8_SB(0, 1), cB + hstepB, voffB); PG8_STAGE(PG8_SA(0, 1), cA + hstepA, voffA);
    if (wr == 1) PG8_BAR;
    PG8_WAIT_V(4); PG8_BAR;
    PG8_STAGE(PG8_SB(1, 0), cB + kstep, voffB); PG8_STAGE(PG8_SA(1, 0), cA + kstep, voffA); PG8_STAGE(PG8_SB(1, 1), cB + hstepB + kstep, voffB);
    PG8_WAIT_V(6); PG8_BAR;
    for (;;) {
        const bool has_next = S.next(ui + 1, nxt);
        const char* nA = has_next ? (const char*)g.A + (size_t)nxt.pm * 256 * g.lda * 2 : cA; const char* nB = has_next ? (const char*)g.Bt + PG8_BROW(nxt.pn) * (size_t)g.ldb * 2 : cB;
        for (int t = 0; t < nt; t += 2) {
            const bool last = (t == nt - 2);
            const char* a1 = cA + (size_t)(t + 1) * kstep;
            const char* a2 = last ? nA : cA + (size_t)(t + 2) * kstep; const char* b2 = last ? nB : cB + (size_t)(t + 2) * kstep;
            const char* a3 = a2 + kstep; const char* b3 = b2 + kstep;
            PG8_LDB(B0, 0, 0); PG8_SCHED; PG8_LDA(At, 0, 0); PG8_STAGE(PG8_SA(1, 1), a1 + hstepA, voffA);
            PG8_WAIT_L(8); PG8_BAR; PG8_WAIT_L(0); PG8_MMA(0, 0, At, B0); PG8_BAR; PG8_SCHED;
            PG8_LDB(B1, 0, 1); PG8_STAGE(PG8_SB(0, 0), b2, voffB);
            PG8_BAR; PG8_WAIT_L(0); PG8_MMA(0, 1, At, B1); PG8_BAR;
            PG8_LDA(At, 0, 1); PG8_STAGE(PG8_SA(0, 0), a2, voffA);
            PG8_BAR; PG8_WAIT_L(0); PG8_MMA(1, 0, At, B0); PG8_BAR; PG8_SCHED;
            PG8_STAGE(PG8_SB(0, 1), b2 + hstepB, voffB);
            PG8_WAIT_V(6); PG8_BAR; PG8_MMA(1, 1, At, B1); PG8_BAR;
            PG8_LDB(B0, 1, 0); PG8_SCHED; PG8_LDA(At, 1, 0); PG8_STAGE(PG8_SA(0, 1), a2 + hstepA, voffA);
            PG8_WAIT_L(8); PG8_BAR; PG8_WAIT_L(0); PG8_MMA(0, 0, At, B0); PG8_BAR; PG8_SCHED;
            PG8_LDB(B1, 1, 1); PG8_STAGE(PG8_SB(1, 0), b3, voffB);
            PG8_BAR; PG8_WAIT_L(0); PG8_MMA(0, 1, At, B1); PG8_BAR;
            PG8_LDA(At, 1, 1); PG8_STAGE(PG8_SA(1, 0), a3, voffA);
            PG8_BAR; PG8_WAIT_L(0); PG8_MMA(1, 0, At, B0); PG8_BAR; PG8_SCHED;
            PG8_STAGE(PG8_SB(1, 1), b3 + hstepB, voffB);
            PG8_WAIT_V(6); PG8_BAR; PG8_MMA(1, 1, At, B1); PG8_BAR;
        }
        E(acc, cur, wr, wc, fr, fq);
        if (!has_next) break;
#pragma unroll
        for (int a = 0; a < 2; ++a)
#pragma unroll
            for (int b = 0; b < 2; ++b)
#pragma unroll
                for (int m = 0; m < 4; ++m)
#pragma unroll
                    for (int n = 0; n < 2; ++n) acc[a][b][m][n] = (f32x4){0.f, 0.f, 0.f, 0.f};
        cur = nxt; cA = nA; cB = nB; ++ui;
    }
    PG8_WAIT_V(0);
    if (wr == 0) PG8_BAR;
    PG8_BAR;
#undef PG8_BROW
#undef PG8_SA
#undef PG8_SB
#undef PG8_STAGE
#undef PG8_LDA
#undef PG8_LDB
#undef PG8_MMA
#undef PG8_WAIT_V
#undef PG8_WAIT_L
#undef PG8_BAR
#undef PG8_SCHED
}

DI void transpose_item(const float* W, int K, int ldw, int nblk, bf16_t* WT, LAS float* scr, int item, int lane) {
    const int kb = item / nblk, nb = item % nblk, k0 = 64 * kb, n0 = 32 * nb;
    float wv_[32];
#pragma unroll
    for (int i = 0; i < 32; ++i) { const int kk = 2 * i + (lane >> 5); wv_[i] = W[(size_t)(k0 + kk) * ldw + n0 + (lane & 31)]; }
#pragma unroll
    for (int i = 0; i < 32; ++i) { const int kk = 2 * i + (lane >> 5); scr[kk * 33 + (lane & 31)] = wv_[i]; }
    asm volatile("s_waitcnt lgkmcnt(0)" ::: "memory");
    const int c = lane & 7;
#pragma unroll
    for (int j = 0; j < 4; ++j) { const int n = (lane >> 3) + 8 * j; const LAS float* s = scr + (8 * c) * 33 + n;
        u32x4 o; o.x = pk2(s[0 * 33], s[1 * 33]); o.y = pk2(s[2 * 33], s[3 * 33]); o.z = pk2(s[4 * 33], s[5 * 33]); o.w = pk2(s[6 * 33], s[7 * 33]);
        *(u32x4*)(WT + (size_t)(n0 + n) * K + k0 + 8 * c) = o; }
    asm volatile("s_waitcnt lgkmcnt(0)" ::: "memory");
}
DI int layer_base(int layer) { return layer == 0 ? 1 : layer == 1 ? 14 : layer == 2 ? 22 : 33; }
DI int wout_idx(int layer) { const int kind = layer % 3; return layer_base(layer) + (kind == 0 ? 6 : kind == 1 ? 1 : 4); }
DI void wprep_layer(int wv, LAS unsigned char* lds, const Params& p, int layer, bf16_t* wb) {
    const int kind = layer % 3, nin = kind == 1 ? 9216 : 3072, ldw_in = kind == 1 ? 9216 : kind == 2 ? 3088 : 3072;
    const int wo = wout_idx(layer);
    const float* w_in = p.in[layer_base(layer)]; const float* w_out = p.in[wo]; const float* w1 = p.in[wo + 3]; const float* w2 = p.in[wo + 4];
    bf16_t* wb_out = wb + (size_t)nin * 1024; bf16_t* wb_1 = wb_out + 1024 * 1024; bf16_t* wb_2 = wb_1 + 4096 * 1024;
    const int tid = mk_tid(wv), wid = tid >> 6, lane = tid & 63; const int bid = opaque_bid();
    LAS float* scr = (LAS float*)(lds + wid * 8448);
    const int I0 = 16 * (nin / 32), I1 = 16 * 32, I2 = 16 * 128, I3 = 64 * 32, tot = I0 + I1 + I2 + I3;
    for (int it = bid * 8 + wid; it < tot; it += gridDim.x * 8) {
        int r = it;
        if (r < I0) { transpose_item(w_in, 1024, ldw_in, nin / 32, wb, scr, r, lane); continue; } r -= I0;
        if (r < I1) { transpose_item(w_out, 1024, 1024, 32, wb_out, scr, r, lane); continue; } r -= I1;
        if (r < I2) { transpose_item(w1, 1024, 4096, 128, wb_1, scr, r, lane); continue; } r -= I2;
        transpose_item(w2, 4096, 1024, 32, wb_2, scr, r, lane);
    }
}
DI void xconvert(int wv, const float* x, bf16_t* xb) {
    const size_t n8 = (size_t)M_TOK * DM / 8;
    const size_t st_ = (size_t)gridDim.x * 512;
    for (size_t i = (size_t)opaque_bid() * 512 + mk_tid(wv); i < n8; i += 4 * st_) {
        f32x4 a[4], b[4];
#pragma unroll
        for (int u = 0; u < 4; ++u) { const size_t j = (i + u * st_ < n8) ? i + u * st_ : i; a[u] = ((const f32x4*)x)[2 * j]; b[u] = ((const f32x4*)x)[2 * j + 1]; }
#pragma unroll
        for (int u = 0; u < 4; ++u) if (i + u * st_ < n8) { u32x4 w; w.x = pk2(a[u].x, a[u].y); w.y = pk2(a[u].z, a[u].w); w.z = pk2(b[u].x, b[u].y); w.w = pk2(b[u].z, b[u].w);
            ((u32x4*)xb)[i + u * st_] = w; }
    }
}
DI void ln_phase(int wv, const bf16_t* y, float* xo, const float* g, const float* bta, bf16_t* xb) {
    const int tid = mk_tid(wv), wid = tid >> 6, lane = tid & 63; const int bid = opaque_bid();
    f32x4 gv[4], bv[4];
#pragma unroll
    for (int j = 0; j < 2; ++j) { gv[2 * j] = *(const f32x4*)(g + j * 512 + lane * 8); gv[2 * j + 1] = *(const f32x4*)(g + j * 512 + lane * 8 + 4);
                                  bv[2 * j] = *(const f32x4*)(bta + j * 512 + lane * 8); bv[2 * j + 1] = *(const f32x4*)(bta + j * 512 + lane * 8 + 4); }
    const int nw = gridDim.x * 8;
    constexpr int R = 4;
    for (int row0 = bid * 8 + wid; row0 < M_TOK; row0 += R * nw) {
        u32x4 raw[R][2], rsd[R][2];
#pragma unroll
        for (int r = 0; r < R; ++r) { const int row = (row0 + r * nw < M_TOK) ? row0 + r * nw : row0;
#pragma unroll
            for (int j = 0; j < 2; ++j) { raw[r][j] = *(const u32x4*)(y + (size_t)row * DM + j * 512 + lane * 8); rsd[r][j] = *(const u32x4*)(xb + (size_t)row * DM + j * 512 + lane * 8); } }
#pragma unroll
        for (int r = 0; r < R; ++r) {
            const int row = row0 + r * nw;
            if (row < M_TOK) {
                f32x4 v[4];
#pragma unroll
                for (int j = 0; j < 2; ++j) { const u32x4 q = raw[r][j], x_ = rsd[r][j];
                    v[2 * j] = (f32x4){__uint_as_float(q.x << 16), __uint_as_float(q.x & 0xffff0000u), __uint_as_float(q.y << 16), __uint_as_float(q.y & 0xffff0000u)}
                             + (f32x4){__uint_as_float(x_.x << 16), __uint_as_float(x_.x & 0xffff0000u), __uint_as_float(x_.y << 16), __uint_as_float(x_.y & 0xffff0000u)} * ALPHA_RES;
                    v[2 * j + 1] = (f32x4){__uint_as_float(q.z << 16), __uint_as_float(q.z & 0xffff0000u), __uint_as_float(q.w << 16), __uint_as_float(q.w & 0xffff0000u)}
                                 + (f32x4){__uint_as_float(x_.z << 16), __uint_as_float(x_.z & 0xffff0000u), __uint_as_float(x_.w << 16), __uint_as_float(x_.w & 0xffff0000u)} * ALPHA_RES; }
                float s_ = 0.f;
#pragma unroll
                for (int j = 0; j < 4; ++j) s_ += (v[j].x + v[j].y) + (v[j].z + v[j].w);
                const float mean = wave_sum(s_) * (1.f / DM); float s2 = 0.f;
#pragma unroll
                for (int j = 0; j < 4; ++j) { v[j] = v[j] - mean; s2 += (v[j].x * v[j].x + v[j].y * v[j].y) + (v[j].z * v[j].z + v[j].w * v[j].w); }
                const float rstd = 1.f / sqrtf(wave_sum(s2) * (1.f / DM) + 1e-5f);
#pragma unroll
                for (int j = 0; j < 2; ++j) { const f32x4 y0 = v[2 * j] * rstd * gv[2 * j] + bv[2 * j], y1 = v[2 * j + 1] * rstd * gv[2 * j + 1] + bv[2 * j + 1];
                    if (xo) { *(f32x4*)(xo + (size_t)row * DM + j * 512 + lane * 8) = y0; *(f32x4*)(xo + (size_t)row * DM + j * 512 + lane * 8 + 4) = y1; }
                    u32x4 w; w.x = pk2(y0.x, y0.y); w.y = pk2(y0.z, y0.w); w.z = pk2(y1.x, y1.y); w.w = pk2(y1.z, y1.w);
                    *(u32x4*)(xb + (size_t)row * DM + j * 512 + lane * 8) = w; }
            }
        }
    }
}

constexpr int DA_KP = 272, DA_VP = 144, DA_KB = 64 * DA_KP, DA_BUF = DA_KB + 128 * DA_VP;
DI void diff_attn_phase(int wv, LAS unsigned char* lds, const bf16_t* qk, const bf16_t* vt, bf16_t* ob, const float* lq1, const float* lk1, const float* lq2, const float* lk2,
                        const float* subg, int layer_idx) {
    const int tid = mk_tid(wv), wid = __builtin_amdgcn_readfirstlane(tid >> 6), lane = tid & 63, rr = lane & 31, hh = lane >> 5; const int bid = opaque_bid();
    const int map = wid >> 2, qsub = wid & 3;
    int li_ = layer_idx; asm volatile("" : "+s"(li_)); const float lambda_init = (li_ == 0) ? 0.2f : 0.5560582041f;
    const float d1 = wave_sum(lq1[lane] * lk1[lane]), d2 = wave_sum(lq2[lane] * lk2[lane]);
    const float lam = expf(d1) - expf(d2) + lambda_init;
    LAS float* xch = (LAS float*)lds;
    const float c1 = 0.125f * LOG2E;
    const int prr = (rr & 0x13) | ((rr & 4) << 1) | ((rr & 8) >> 1);
    const int koff = prr * DA_KP + (map * 64 + hh * 8) * 2;
    const int voff = DA_KB + rr * DA_VP + hh * 16;
    const int krow0 = tid >> 4, kch = tid & 15, vrow0 = tid >> 3, vch = tid & 7;
    const int kst_off = krow0 * DA_KP + kch * 16, vst_off = DA_KB + vrow0 * DA_VP + vch * 16;
    u32x4 gk[2], gv[2]; bool have_pf = false;
    for (int it = bid; it < 2048; it += gridDim.x) {
        const int rho = it >> 8, j = it & 255, grp = j >> 6, bh = j & 63;
        const int qb = 28 - 4 * rho + ((rho & 1) ? grp : 3 - grp);
        const int b = bh >> 3, hd = bh & 7;
        const int q0 = qb * 128 + qsub * 32, nkt = 2 * qb + 2, qpos = q0 + rr;
        const float slope2 = exp2f(-(float)(hd + 1)) * LOG2E;
        const bf16_t* qkb = qk + (size_t)b * SEQ * 2048;
        LAS unsigned char* qlds = lds + 2 * DA_BUF + wid * 4096 + lane * 16;
#pragma unroll
        for (int ks = 0; ks < 4; ++ks) *(LAS bf16x8*)(qlds + ks * 1024) = *(const bf16x8*)(qkb + (size_t)(q0 + rr) * 2048 + hd * 128 + map * 64 + ks * 16 + hh * 8);
        const bf16_t* kg = qkb + 1024 + hd * 128 + kch * 8 + (size_t)krow0 * 2048;
        const bf16_t* vg = vt + (size_t)(hd * 128 + vrow0) * M_TOK + (size_t)b * SEQ + vch * 8;
        float cb[16];
#pragma unroll
        for (int i = 0; i < 16; ++i) cb[i] = slope2 * (float)((i & 7) + 16 * (i >> 3));
        f32x16 O[4];
#pragma unroll
        for (int d = 0; d < 4; ++d) O[d] = zero16();
        float m = -INFINITY, l = 0.f;
        if (!have_pf) {
#pragma unroll
            for (int i = 0; i < 2; ++i) { gk[i] = *(const u32x4*)(kg + (size_t)i * 32 * 2048); gv[i] = *(const u32x4*)(vg + (size_t)i * 64 * M_TOK); } }
#pragma unroll
        for (int i = 0; i < 2; ++i) { *(LAS u32x4*)(lds + kst_off + i * 32 * DA_KP) = gk[i]; *(LAS u32x4*)(lds + vst_off + i * 64 * DA_VP) = gv[i]; }
        __syncthreads();
        const int tmain = 2 * qb;
#pragma nounroll
        for (int t = 0; t < tmain; ++t) {
            const int key0 = t * 64;
            const bool more = true;
            if (more) {
#pragma unroll
                for (int i = 0; i < 2; ++i) gk[i] = *(const u32x4*)(kg + (size_t)(key0 + 64 + i * 32) * 2048); }
            LAS unsigned char* buf = lds + (t & 1) * DA_BUF;
            {
                f32x16 S0 = zero16(), S1 = zero16();
                {
                    bf16x8 kf[2][4];
#pragma unroll
                    for (int sub = 0; sub < 2; ++sub)
#pragma unroll
                        for (int ks = 0; ks < 4; ++ks) kf[sub][ks] = *(const LAS bf16x8*)(buf + koff + sub * 32 * DA_KP + ks * 32);
#pragma unroll
                    for (int ks = 0; ks < 4; ++ks) { const bf16x8 qfr = *(const LAS bf16x8*)(qlds + ks * 1024); S0 = MFMA32(kf[0][ks], qfr, S0); S1 = MFMA32(kf[1][ks], qfr, S1); }
                }
                __builtin_amdgcn_sched_barrier(0);
#pragma unroll
                for (int i = 0; i < 2; ++i) gv[i] = *(const u32x4*)(vg + (size_t)i * 64 * M_TOK + key0 + 64);
                bf16x8 vf[4][2];
#pragma unroll
                for (int d = 0; d < 4; ++d)
#pragma unroll
                    for (int s2 = 0; s2 < 2; ++s2) vf[d][s2] = *(const LAS bf16x8*)(buf + voff + d * 32 * DA_VP + (16 * s2) * 2);
                const float base = slope2 * (float)(key0 + 8 * hh - qpos), b32 = 32.f * slope2;
#pragma unroll
                for (int i = 0; i < 16; ++i) { S0[i] = S0[i] * c1 + cb[i]; S1[i] = S1[i] * c1 + cb[i]; }
                float mx = -INFINITY, mx1 = -INFINITY;
#pragma unroll
                for (int i = 0; i < 16; ++i) { mx = fmaxf(mx, S0[i]); mx1 = fmaxf(mx1, S1[i]); }
                mx = fmaxf(mx, mx1 + b32) + base;
                mx = fmaxf(mx, __shfl_xor(mx, 32));
                {
                    const float mn = fmaxf(m, mx), alpha = fexp2(m - mn); m = mn; l *= alpha;
#pragma unroll
                    for (int d = 0; d < 4; ++d) O[d] = O[d] * alpha;
                }
                const float off = base - m, off1 = off + b32;
                float ps = 0.f;
#pragma unroll
                for (int i = 0; i < 16; ++i) { S0[i] = fexp2(S0[i] + off); S1[i] = fexp2(S1[i] + off1); ps += S0[i] + S1[i]; }
                l += ps;
                const bf16x8 p0 = pack8(S0, 0), p1 = pack8(S0, 1), p2 = pack8(S1, 0), p3 = pack8(S1, 1);
                __builtin_amdgcn_sched_barrier(0);
#pragma unroll
                for (int d = 0; d < 4; ++d) { O[d] = MFMA32(vf[d][0], p0, O[d]); O[d] = MFMA32(vf[d][1], p1, O[d]); }
                __builtin_amdgcn_sched_barrier(0);
#pragma unroll
                for (int d = 0; d < 4; ++d)
#pragma unroll
                    for (int s2 = 0; s2 < 2; ++s2) vf[d][s2] = *(const LAS bf16x8*)(buf + voff + d * 32 * DA_VP + (32 + 16 * s2) * 2);
#pragma unroll
                for (int d = 0; d < 4; ++d) { O[d] = MFMA32(vf[d][0], p2, O[d]); O[d] = MFMA32(vf[d][1], p3, O[d]); }
            }
            if (more) {
                LAS unsigned char* nb = lds + ((t + 1) & 1) * DA_BUF;
#pragma unroll
                for (int i = 0; i < 2; ++i) { *(LAS u32x4*)(nb + kst_off + i * 32 * DA_KP) = gk[i]; *(LAS u32x4*)(nb + vst_off + i * 64 * DA_VP) = gv[i]; } }
            __syncthreads();
        }
        for (int t = tmain; t < nkt; ++t) {
            const int key0 = t * 64;
            const bool more = (t + 1 < nkt);
            if (more) {
#pragma unroll
                for (int i = 0; i < 2; ++i) { gk[i] = *(const u32x4*)(kg + (size_t)(key0 + 64 + i * 32) * 2048); gv[i] = *(const u32x4*)(vg + (size_t)i * 64 * M_TOK + key0 + 64); } }
            else if (it + (int)gridDim.x < 2048) {
                const int itn = it + (int)gridDim.x, bhn = itn & 63, bn = bhn >> 3, hdn = bhn & 7;
                const bf16_t* kgn = qk + (size_t)bn * SEQ * 2048 + 1024 + hdn * 128 + kch * 8 + (size_t)krow0 * 2048;
                const bf16_t* vgn = vt + (size_t)(hdn * 128 + vrow0) * M_TOK + (size_t)bn * SEQ + vch * 8;
#pragma unroll
                for (int i = 0; i < 2; ++i) { gk[i] = *(const u32x4*)(kgn + (size_t)i * 32 * 2048); gv[i] = *(const u32x4*)(vgn + (size_t)i * 64 * M_TOK); }
                have_pf = true; }
            LAS unsigned char* buf = lds + (t & 1) * DA_BUF;
            if (key0 <= q0 + 31) {
                f32x16 S0 = zero16(), S1 = zero16();
                {
                    bf16x8 kf[2][4];
#pragma unroll
                    for (int sub = 0; sub < 2; ++sub)
#pragma unroll
                        for (int ks = 0; ks < 4; ++ks) kf[sub][ks] = *(const LAS bf16x8*)(buf + koff + sub * 32 * DA_KP + ks * 32);
#pragma unroll
                    for (int ks = 0; ks < 4; ++ks) { const bf16x8 qfr = *(const LAS bf16x8*)(qlds + ks * 1024); S0 = MFMA32(kf[0][ks], qfr, S0); S1 = MFMA32(kf[1][ks], qfr, S1); }
                }
                __builtin_amdgcn_sched_barrier(0);
                bf16x8 vf[4][2];
#pragma unroll
                for (int d = 0; d < 4; ++d)
#pragma unroll
                    for (int s2 = 0; s2 < 2; ++s2) vf[d][s2] = *(const LAS bf16x8*)(buf + voff + d * 32 * DA_VP + (16 * s2) * 2);
                const float base = slope2 * (float)(key0 + 8 * hh - qpos), b32 = 32.f * slope2;
#pragma unroll
                for (int i = 0; i < 16; ++i) { S0[i] = S0[i] * c1 + cb[i]; S1[i] = S1[i] * c1 + cb[i]; }
                if (key0 + 63 > q0) {
                    const int kq = qpos - key0 - 8 * hh;
#pragma unroll
                    for (int i = 0; i < 16; ++i) { const int ko = (i & 7) + 16 * (i >> 3); S0[i] = (ko > kq) ? -INFINITY : S0[i]; S1[i] = (ko + 32 > kq) ? -INFINITY : S1[i]; }
                }
                float mx = -INFINITY, mx1 = -INFINITY;
#pragma unroll
                for (int i = 0; i < 16; ++i) { mx = fmaxf(mx, S0[i]); mx1 = fmaxf(mx1, S1[i]); }
                mx = fmaxf(mx, mx1 + b32) + base;
                mx = fmaxf(mx, __shfl_xor(mx, 32));
                {
                    const float mn = fmaxf(m, mx), alpha = fexp2(m - mn); m = mn; l *= alpha;
#pragma unroll
                    for (int d = 0; d < 4; ++d) O[d] = O[d] * alpha;
                }
                const float off = base - m, off1 = off + b32;
                float ps = 0.f;
#pragma unroll
                for (int i = 0; i < 16; ++i) { S0[i] = fexp2(S0[i] + off); S1[i] = fexp2(S1[i] + off1); ps += S0[i] + S1[i]; }
                l += ps;
                const bf16x8 p0 = pack8(S0, 0), p1 = pack8(S0, 1), p2 = pack8(S1, 0), p3 = pack8(S1, 1);
                __builtin_amdgcn_sched_barrier(0);
#pragma unroll
                for (int d = 0; d < 4; ++d) { O[d] = MFMA32(vf[d][0], p0, O[d]); O[d] = MFMA32(vf[d][1], p1, O[d]); }
                __builtin_amdgcn_sched_barrier(0);
#pragma unroll
                for (int d = 0; d < 4; ++d)
#pragma unroll
                    for (int s2 = 0; s2 < 2; ++s2) vf[d][s2] = *(const LAS bf16x8*)(buf + voff + d * 32 * DA_VP + (32 + 16 * s2) * 2);
#pragma unroll
                for (int d = 0; d < 4; ++d) { O[d] = MFMA32(vf[d][0], p2, O[d]); O[d] = MFMA32(vf[d][1], p3, O[d]); }
            }
            if (more) {
                LAS unsigned char* nb = lds + ((t + 1) & 1) * DA_BUF;
#pragma unroll
                for (int i = 0; i < 2; ++i) { *(LAS u32x4*)(nb + kst_off + i * 32 * DA_KP) = gk[i]; *(LAS u32x4*)(nb + vst_off + i * 64 * DA_VP) = gv[i]; } }
            __syncthreads();
        }
        const float lt = l + __shfl_xor(l, 32), inv = 1.f / lt;
        if (map == 1) { const float f = lam * inv;
#pragma unroll
            for (int d = 0; d < 4; ++d)
#pragma unroll
                for (int i = 0; i < 16; ++i) xch[((qsub * 4 + d) * 16 + i) * 64 + lane] = O[d][i] * f; }
        __syncthreads();
        if (map == 0) {
            float ss = 0.f;
#pragma unroll
            for (int d = 0; d < 4; ++d)
#pragma unroll
                for (int i = 0; i < 16; ++i) { const float o = O[d][i] * inv - xch[((qsub * 4 + d) * 16 + i) * 64 + lane]; O[d][i] = o; ss += o * o; }
            ss += __shfl_xor(ss, 32);
            const float rn = (1.f / sqrtf(ss * (1.f / 128.f) + 1e-6f)) * (1.f - lambda_init);
            bf16_t* orow = ob + (size_t)(b * SEQ + q0 + rr) * 1024 + hd * 128;
#pragma unroll
            for (int d = 0; d < 4; ++d)
#pragma unroll
                for (int gq = 0; gq < 4; ++gq) { const int dv0 = d * 32 + 8 * gq + 4 * hh; const f32x4 g4 = *(const f32x4*)(subg + dv0);
                    u32x2 w; w.x = pk2(O[d][4 * gq] * rn * g4.x, O[d][4 * gq + 1] * rn * g4.y); w.y = pk2(O[d][4 * gq + 2] * rn * g4.z, O[d][4 * gq + 3] * rn * g4.w);
                    *(u32x2*)(orow + dv0) = w; }
        }
        __syncthreads();
    }
}

DI void dil_attn_phase(int wv, const bf16_t* qk, const bf16_t* vt, float* oacc, float* stats, bf16_t* ob, int g, int dil) {
    const int tid = mk_tid(wv), wid = __builtin_amdgcn_readfirstlane(tid >> 6), lane = tid & 63, rr = lane & 31, hh = lane >> 5; const int bid = opaque_bid();
    const int L = SEQ / dil, ntl = L / 32; const int prr = (rr & 0x13) | ((rr & 4) << 1) | ((rr & 8) >> 1);
    const float c1 = 0.08838834764831845f * LOG2E;
    for (int task = bid * 8 + wid; task < 8192; task += gridDim.x * 8) {
        const int lt = task % ntl; int t2 = task / ntl; const int head = t2 & 7; t2 >>= 3; const int rph = t2 % dil, b = t2 / dil;
        const int l0 = lt * 32;
        const float slope2d = exp2f(-(float)(head + 1)) * LOG2E * (float)dil;
        const size_t qrow = (size_t)b * SEQ + (size_t)(l0 + rr) * dil + rph;
        bf16x8 qf[8];
#pragma unroll
        for (int ks = 0; ks < 8; ++ks) qf[ks] = *(const bf16x8*)(qk + qrow * 2048 + head * 128 + ks * 16 + hh * 8);
        f32x16 O[4];
#pragma unroll
        for (int d = 0; d < 4; ++d) O[d] = zero16();
        float m = -INFINITY, l = 0.f;
        for (int jt = 0; jt < 5; ++jt) {
            const int kl0 = l0 - 128 + 32 * jt;
            if (kl0 < 0) continue;
            const size_t krow = (size_t)b * SEQ + (size_t)(kl0 + prr) * dil + rph;
            bf16x8 kf[8];
#pragma unroll
            for (int ks = 0; ks < 8; ++ks) kf[ks] = *(const bf16x8*)(qk + krow * 2048 + 1024 + head * 128 + ks * 16 + hh * 8);
            const bf16_t* vb = vt + (size_t)(head * 128 + rr) * M_TOK + (size_t)b * SEQ + (size_t)rph * L + kl0 + 8 * hh;
            bf16x8 vf[4][2];
#pragma unroll
            for (int d = 0; d < 4; ++d)
#pragma unroll
                for (int s = 0; s < 2; ++s) vf[d][s] = *(const bf16x8*)(vb + (size_t)d * 32 * M_TOK + 16 * s);
            f32x16 S = zero16();
#pragma unroll
            for (int ks = 0; ks < 8; ++ks) S = MFMA32(kf[ks], qf[ks], S);
            float sv[16]; float mx = -INFINITY;
#pragma unroll
            for (int i = 0; i < 16; ++i) { const int dist = (l0 + rr) - (kl0 + (i & 7) + 16 * (i >> 3) + 8 * hh); float v = S[i] * c1 - slope2d * (float)dist; v = (dist >= 0 && dist <= 128) ? v : -INFINITY; sv[i] = v; mx = fmaxf(mx, v); }
            mx = fmaxf(mx, __shfl_xor(mx, 32));
            const float mn = fmaxf(m, mx), alpha = fexp2(m - mn); m = mn;
            float ps = 0.f; f32x16 P;
#pragma unroll
            for (int i = 0; i < 16; ++i) { const float pv = fexp2(sv[i] - mn); P[i] = pv; ps += pv; }
            l = l * alpha + ps;
#pragma unroll
            for (int d = 0; d < 4; ++d) O[d] = O[d] * alpha;
            const bf16x8 pf0 = pack8(P, 0), pf1 = pack8(P, 1);
#pragma unroll
            for (int d = 0; d < 4; ++d) { O[d] = MFMA32(vf[d][0], pf0, O[d]); O[d] = MFMA32(vf[d][1], pf1, O[d]); }
        }
        const float ltot = l + __shfl_xor(l, 32), inv = 1.f / ltot, lse2 = m + log2f(ltot);
        float* st = stats + (qrow * 8 + head) * 2;
        float a = 0.f, bw = 1.f, lrun = 1.f, mrun = lse2;
        if (g > 0) { const float m0 = st[0], lr0 = st[1]; const float mn = fmaxf(m0, lse2); a = fexp2(m0 - mn); bw = fexp2(lse2 - mn); lrun = lr0 * a + bw; mrun = mn; }
        float* orow = oacc + qrow * 1024 + head * 128;
        bf16_t* obrow = ob + qrow * 1024 + head * 128;
        const float f = inv * bw, il = 1.f / lrun;
#pragma unroll
        for (int d = 0; d < 4; ++d)
#pragma unroll
            for (int gq = 0; gq < 4; ++gq) { const int dv0 = d * 32 + 8 * gq + 4 * hh;
                f32x4 o = {O[d][4 * gq] * f, O[d][4 * gq + 1] * f, O[d][4 * gq + 2] * f, O[d][4 * gq + 3] * f};
                if (g > 0) { const f32x4 old = *(const f32x4*)(orow + dv0); o = o + old * a; }
                if (g < 2) *(f32x4*)(orow + dv0) = o;
                else { u32x2 w; w.x = pk2(o.x * il, o.y * il); w.y = pk2(o.z * il, o.w * il); *(u32x2*)(obrow + dv0) = w; } }
        if (g < 2 && hh == 0) { st[0] = mrun; st[1] = lrun; }
    }
}

DI float logsig(float z) { return fminf(z, 0.f) - __logf(1.f + __expf(-fabsf(z))); }
DI void gla_gate_phase(int wv, LAS unsigned char* lds, const float* x, const float* w_in, const float* w2, const float* bg, const bf16_t* qk1,
                       bf16_t* qd, bf16_t* ki, bf16_t* kst, float* decay, bf16_t* sbuf) {
    const int tid = mk_tid(wv), wid = tid >> 6, lane = tid & 63, rr = lane & 31, hh = lane >> 5; const int bid = opaque_bid();
    LAS float* wg = (LAS float*)lds;
    LAS float* gl = (LAS float*)(lds + 65536);
#pragma unroll
    for (int i = 0; i < 8; ++i) { const int idx = tid + 512 * i, k = idx >> 2, n4 = (idx & 3) * 4; *(LAS f32x4*)(wg + k * 16 + n4) = *(const f32x4*)(w_in + (size_t)k * 3088 + 3072 + n4); }
    __syncthreads();
    const int c = tid;
    float w2c[16];
#pragma unroll
    for (int j = 0; j < 16; ++j) w2c[j] = w2[j * 512 + c];
    const float bc = bg[c];
    for (int it = bid; it < 512; it += gridDim.x) {
        const int b = it >> 6, ch = it & 63; const size_t T0 = (size_t)b * SEQ + ch * 64;
        for (int tt = 0; tt < 8; tt += 2) {
            const size_t t0 = T0 + wid * 8 + tt;
            float a0[16], a1[16];
#pragma unroll
            for (int n = 0; n < 16; ++n) { a0[n] = 0.f; a1[n] = 0.f; }
#pragma unroll
            for (int i = 0; i < 16; ++i) { const int k = lane + 64 * i; const float x0 = x[t0 * DM + k], x1 = x[(t0 + 1) * DM + k];
#pragma unroll
                for (int q = 0; q < 4; ++q) { const f32x4 w = *(const LAS f32x4*)(wg + k * 16 + 4 * q);
                    a0[4 * q] += x0 * w.x; a0[4 * q + 1] += x0 * w.y; a0[4 * q + 2] += x0 * w.z; a0[4 * q + 3] += x0 * w.w;
                    a1[4 * q] += x1 * w.x; a1[4 * q + 1] += x1 * w.y; a1[4 * q + 2] += x1 * w.z; a1[4 * q + 3] += x1 * w.w; } }
            float v0 = 0.f, v1 = 0.f;
#pragma unroll
            for (int n = 0; n < 16; ++n) { const float s0 = wave_sum(a0[n]), s1 = wave_sum(a1[n]); v0 = (lane == n) ? s0 : v0; v1 = (lane == n) ? s1 : v1; }
            if (lane < 16) { gl[(wid * 8 + tt) * 16 + lane] = v0; gl[(wid * 8 + tt + 1) * 16 + lane] = v1; }
        }
        __syncthreads();
        float cum = 0.f;
#pragma unroll 4
        for (int t = 0; t < 64; ++t) { float z = bc;
#pragma unroll
            for (int q = 0; q < 4; ++q) { const f32x4 gv = *(const LAS f32x4*)(gl + t * 16 + 4 * q); z += gv.x * w2c[4 * q] + gv.y * w2c[4 * q + 1] + gv.z * w2c[4 * q + 2] + gv.w * w2c[4 * q + 3]; }
            cum += logsig(z) * 0.0625f; }
        const float blast = cum;
        decay[((size_t)b * 64 + ch) * 512 + c] = __expf(blast);
        cum = 0.f;
        for (int t8 = 0; t8 < 64; t8 += 8) {
            float ksv[8];
#pragma unroll
            for (int u = 0; u < 8; ++u) { const int t = t8 + u; float z = bc;
#pragma unroll
                for (int q = 0; q < 4; ++q) { const f32x4 gv = *(const LAS f32x4*)(gl + t * 16 + 4 * q); z += gv.x * w2c[4 * q] + gv.y * w2c[4 * q + 1] + gv.z * w2c[4 * q + 2] + gv.w * w2c[4 * q + 3]; }
                cum += logsig(z) * 0.0625f;
                const size_t tok = T0 + t;
                const float qv = bf2f(qk1[tok * 1024 + c]), kv = bf2f(qk1[tok * 1024 + 512 + c]);
                qd[tok * 512 + c] = f2bf(qv * 0.08838834764831845f * __expf(cum));
                ki[tok * 512 + c] = f2bf(kv * __expf(-cum));
                ksv[u] = kv * __expf(blast - cum); }
            u32x4 w; w.x = pk2(ksv[0], ksv[1]); w.y = pk2(ksv[2], ksv[3]); w.z = pk2(ksv[4], ksv[5]); w.w = pk2(ksv[6], ksv[7]);
            *(u32x4*)(kst + ((size_t)b * 512 + c) * SEQ + ch * 64 + t8) = w;
        }
        __syncthreads();
        const int hd = wid >> 1;
#pragma unroll
        for (int u = 0; u < 2; ++u) {
            const int tt2 = (wid & 1) * 2 + u, kt = tt2 >> 1, qt = tt2 & 1;
            f32x16 S = zero16();
            if (!(kt == 1 && qt == 0)) {
#pragma unroll
                for (int ks = 0; ks < 8; ++ks) { const bf16x8 A = *(const bf16x8*)(ki + (T0 + kt * 32 + rr) * 512 + hd * 128 + ks * 16 + hh * 8);
                    const bf16x8 B = *(const bf16x8*)(qd + (T0 + qt * 32 + rr) * 512 + hd * 128 + ks * 16 + hh * 8); S = MFMA32(A, B, S); } }
            const int q = qt * 32 + rr;
            bf16_t* srow = sbuf + (((size_t)b * 4 + hd) * 64 + ch) * 4096 + q * 64 + kt * 32;
#pragma unroll
            for (int gq = 0; gq < 4; ++gq) { const int k0 = 8 * gq + 4 * hh; float v[4];
#pragma unroll
                for (int e = 0; e < 4; ++e) v[e] = (kt * 32 + k0 + e <= q) ? S[4 * gq + e] : 0.f;
                u32x2 w; w.x = pk2(v[0], v[1]); w.y = pk2(v[2], v[3]); *(u32x2*)(srow + k0) = w; }
        }
    }
}
#define SCAN_BAR() do { asm volatile("s_waitcnt lgkmcnt(0)" ::: "memory"); __builtin_amdgcn_s_barrier(); asm volatile("" ::: "memory"); } while (0)
DI void gla_scan_phase(int wv, LAS unsigned char* lds, const bf16_t* qd, const bf16_t* kst, const bf16_t* sbuf, const bf16_t* vt, const float* decay, float* obuf) {
    const int tid = mk_tid(wv), wid = __builtin_amdgcn_readfirstlane(tid >> 6), lane = tid & 63, rr = lane & 31, hh = lane >> 5; const int bid = opaque_bid();
    LAS float* red = (LAS float*)lds;
    for (int task = bid; task < 256; task += gridDim.x) {
        const int dvs = task & 7, hd = (task >> 3) & 3, b = task >> 5;
        const bf16_t* vrow = vt + (size_t)(hd * 256 + dvs * 32) * M_TOK + (size_t)b * SEQ; const unsigned lv = (unsigned)(rr * M_TOK + 8 * hh);
        if (wid < 4) {
            const int kb = wid;
            f32x16 St = zero16();
            const bf16_t* krow = kst + ((size_t)b * 512 + hd * 128 + kb * 32) * SEQ; const unsigned lk = (unsigned)(rr * SEQ + 8 * hh);
            const bf16_t* qp0 = qd + (size_t)b * SEQ * 512 + hd * 128 + kb * 32; const unsigned lq = (unsigned)(rr * 512 + 4 * hh);
            const float* dp0 = decay + (size_t)b * 64 * 512 + hd * 128 + kb * 32; const unsigned ld_ = (unsigned)(4 * hh);
            const int qt = wid >> 1;
            bf16x8 vA[4], kA[4], qB[4]; f32x4 dc[4];
            bf16x8 nvA[4], nkA[4], nqB[4]; f32x4 ndc[4];
#define SCAN_LOADC(c_, vA_, kA_, qB_, dc_) do { \
            _Pragma("unroll") for (int ks = 0; ks < 4; ++ks) { vA_[ks] = *(const bf16x8*)(vrow + (lv + (unsigned)((c_) * 64 + 16 * ks))); kA_[ks] = *(const bf16x8*)(krow + (lk + (unsigned)((c_) * 64 + 16 * ks))); } \
            _Pragma("unroll") for (int s_ = 0; s_ < 2; ++s_) _Pragma("unroll") for (int q_ = 0; q_ < 2; ++q_) { const bf16_t* qp = qp0 + (lq + (unsigned)(((c_) * 64 + q_ * 32) * 512 + 16 * s_)); \
                qB_[2 * s_ + q_] = cat44(*(const s16x4*)qp, *(const s16x4*)(qp + 8)); } \
            _Pragma("unroll") for (int gq = 0; gq < 4; ++gq) dc_[gq] = *(const f32x4*)(dp0 + (ld_ + (unsigned)((c_) * 512 + 8 * gq))); } while (0)
#define SCAN_BODYC(c, vA, kA, qB, dc, nvA, nkA, nqB, ndc) do { \
            const int cn = (c) < 63 ? (c) + 1 : 63; \
            SCAN_LOADC(cn, nvA, nkA, nqB, ndc); \
            LAS float* rb = red + ((c) & 1) * (5 * 2 * 16 * 64); \
            { f32x16 O0 = zero16(), O1 = zero16(); \
              _Pragma("unroll") for (int s_ = 0; s_ < 2; ++s_) { const bf16x8 stA = pack8(St, s_); O0 = MFMA32(stA, qB[2 * s_], O0); O1 = MFMA32(stA, qB[2 * s_ + 1], O1); } \
              LAS float* wp = rb + (wid * 2 * 16) * 64 + lane; \
              _Pragma("unroll") for (int i = 0; i < 16; ++i) { wp[i * 64] = O0[i]; wp[(16 + i) * 64] = O1[i]; } } \
            _Pragma("unroll") for (int gq = 0; gq < 4; ++gq) { St[4 * gq] *= dc[gq].x; St[4 * gq + 1] *= dc[gq].y; St[4 * gq + 2] *= dc[gq].z; St[4 * gq + 3] *= dc[gq].w; } \
            _Pragma("unroll") for (int ks = 0; ks < 4; ++ks) St = MFMA32(kA[ks], vA[ks], St); \
            SCAN_BAR(); \
            { const size_t T0 = (size_t)b * SEQ + (c) * 64; \
              _Pragma("unroll") for (int g2 = 0; g2 < 2; ++g2) { const int gq = 2 * (wid & 1) + g2; f32x4 acc = {0.f, 0.f, 0.f, 0.f}; \
                _Pragma("unroll") for (int sl = 0; sl < 5; ++sl) \
                    _Pragma("unroll") for (int e = 0; e < 4; ++e) acc[e] += rb[((sl * 2 + qt) * 16 + 4 * gq + e) * 64 + lane]; \
                *(f32x4*)(obuf + (T0 + qt * 32 + rr) * 1024 + hd * 256 + dvs * 32 + 8 * gq + 4 * hh) = acc; } } } while (0)
            SCAN_LOADC(0, vA, kA, qB, dc);
#pragma nounroll
            for (int c = 0; c < 64; c += 2) {
                SCAN_BODYC(c, vA, kA, qB, dc, nvA, nkA, nqB, ndc);
                SCAN_BODYC(c + 1, nvA, nkA, nqB, ndc, vA, kA, qB, dc);
            }
#undef SCAN_BODYC
#undef SCAN_LOADC
        } else if (wid == 4) {
            const bf16_t* sb0 = sbuf + ((size_t)b * 4 + hd) * 64 * 4096; const unsigned ls = (unsigned)(rr * 64 + 8 * hh);
            bf16x8 vA[4], sB[6], nvA[4], nsB[6];
#define SCAN_LOADI(c_, vA_, sB_) do { \
            _Pragma("unroll") for (int ks = 0; ks < 4; ++ks) vA_[ks] = *(const bf16x8*)(vrow + (lv + (unsigned)((c_) * 64 + 16 * ks))); \
            _Pragma("unroll") for (int ks = 0; ks < 2; ++ks) sB_[ks] = *(const bf16x8*)(sb0 + (ls + (unsigned)((c_) * 4096 + 16 * ks))); \
            _Pragma("unroll") for (int ks = 0; ks < 4; ++ks) sB_[2 + ks] = *(const bf16x8*)(sb0 + (ls + (unsigned)((c_) * 4096 + 32 * 64 + 16 * ks))); } while (0)
#define SCAN_BODYI(c, vA, sB, nvA, nsB) do { \
            const int cn = (c) < 63 ? (c) + 1 : 63; \
            SCAN_LOADI(cn, nvA, nsB); \
            LAS float* rb = red + ((c) & 1) * (5 * 2 * 16 * 64); \
            f32x16 O0 = zero16(), O1 = zero16(); \
            O0 = MFMA32(vA[0], sB[0], O0); O0 = MFMA32(vA[1], sB[1], O0); \
            _Pragma("unroll") for (int ks = 0; ks < 4; ++ks) O1 = MFMA32(vA[ks], sB[2 + ks], O1); \
            LAS float* wp = rb + (4 * 2 * 16) * 64 + lane; \
            _Pragma("unroll") for (int i = 0; i < 16; ++i) { wp[i * 64] = O0[i]; wp[(16 + i) * 64] = O1[i]; } \
            SCAN_BAR(); } while (0)
            SCAN_LOADI(0, vA, sB);
#pragma nounroll
            for (int c = 0; c < 64; c += 2) {
                SCAN_BODYI(c, vA, sB, nvA, nsB);
                SCAN_BODYI(c + 1, nvA, nsB, vA, sB);
            }
#undef SCAN_BODYI
#undef SCAN_LOADI
        } else {
#pragma nounroll
            for (int c = 0; c < 64; ++c) SCAN_BAR();
        }
        __syncthreads();
    }
}
#undef SCAN_BAR
DI void gla_finish_phase(int wv, const float* obuf, const bf16_t* rb, const float* gn, bf16_t* ob) {
    const int tid = mk_tid(wv), wid = tid >> 6, lane = tid & 63; const int bid = opaque_bid();
    const f32x4 g4 = ((const f32x4*)gn)[lane];
    const int nw = gridDim.x * 8;
    for (int row0 = bid * 8 + wid; row0 < M_TOK; row0 += 2 * nw) {
        f32x4 v[2][4]; u32x2 rw[2][4];
#pragma unroll
        for (int u = 0; u < 2; ++u) { const int row = (row0 + u * nw < M_TOK) ? row0 + u * nw : row0;
#pragma unroll
            for (int i = 0; i < 4; ++i) { v[u][i] = ((const f32x4*)(obuf + (size_t)row * 1024))[lane + 64 * i]; rw[u][i] = ((const u32x2*)(rb + (size_t)row * 1024))[lane + 64 * i]; } }
#pragma unroll
        for (int u = 0; u < 2; ++u) { const int row = row0 + u * nw; if (row < M_TOK) {
#pragma unroll
            for (int i = 0; i < 4; ++i) {
                const f32x4 x = v[u][i];
                const float ss = wave_sum((x.x * x.x + x.y * x.y) + (x.z * x.z + x.w * x.w));
                const float rn = 1.f / sqrtf(ss * (1.f / 256.f) + 1e-6f);
                const u32x2 r_ = rw[u][i];
                const float r0 = __uint_as_float(r_.x << 16), r1 = __uint_as_float(r_.x & 0xffff0000u), r2 = __uint_as_float(r_.y << 16), r3 = __uint_as_float(r_.y & 0xffff0000u);
                const float s0 = r0 / (1.f + expf(-r0)), s1 = r1 / (1.f + expf(-r1)), s2 = r2 / (1.f + expf(-r2)), s3 = r3 / (1.f + expf(-r3));
                u32x2 w; w.x = pk2(x.x * rn * g4.x * s0, x.y * rn * g4.y * s1); w.y = pk2(x.z * rn * g4.z * s2, x.w * rn * g4.w * s3);
                ((u32x2*)(ob + (size_t)row * 1024))[lane + 64 * i] = w;
            } } }
    }
}

DI unsigned xcc_id() { return (unsigned)__builtin_amdgcn_s_getreg((3 << 11) | 20) & 0xFu; }
DI void grid_barrier(int wv, unsigned* bar_, unsigned k, LAS unsigned* stash) {
    unsigned* bar = bar_ + opq_off(0);
    asm volatile("s_waitcnt vmcnt(0) lgkmcnt(0)" ::: "memory");
    __syncthreads();
    if (mk_tid(wv) == 0) {
        const unsigned xcc = xcc_id(), nx = stash[0], nxcc = stash[1];
        const unsigned old = __hip_atomic_fetch_add(bar + 64 * (17 + xcc), 1u, __ATOMIC_RELAXED, __HIP_MEMORY_SCOPE_AGENT);
        if (old == k * nx - 1u) {
            __builtin_amdgcn_fence(__ATOMIC_RELEASE, "agent");
            asm volatile("s_waitcnt vmcnt(0)" ::: "memory");
            const unsigned old2 = __hip_atomic_fetch_add(bar + 64 * 33, 1u, __ATOMIC_RELAXED, __HIP_MEMORY_SCOPE_AGENT);
            if (old2 == k * nxcc - 1u) __hip_atomic_store(bar + 64 * 34, k, __ATOMIC_RELAXED, __HIP_MEMORY_SCOPE_AGENT);
        }
        while (__hip_atomic_load(bar + 64 * 34, __ATOMIC_RELAXED, __HIP_MEMORY_SCOPE_AGENT) < k) __builtin_amdgcn_s_sleep(2);
        __builtin_amdgcn_fence(__ATOMIC_ACQUIRE, "agent");
        asm volatile("s_waitcnt vmcnt(0)" ::: "memory");
    }
    __syncthreads();
}

__global__ void __launch_bounds__(512) mega(Params p) {
    extern __shared__ __attribute__((aligned(16))) unsigned char shm[];
    LAS unsigned char* lds = (LAS unsigned char*)shm;
    cg::grid_group grid = cg::this_grid();
    const int wv = __builtin_amdgcn_readfirstlane((int)threadIdx.x >> 6);
    int ph = 0; unsigned nbar = 0;
    LAS unsigned* stash = (LAS unsigned*)(lds + LDS_PHASE_BYTES);
#define xb ((bf16_t*)(p.ws + opq_off(XB_OFF)))
#define wb ((bf16_t*)(p.ws + opq_off(WB_OFF)))
#define scr (p.ws + opq_off(SCR_OFF))
#define barctr ((unsigned*)(p.ws + opq_off(BAR_OFF)))
#define STT ((float*)(p.ws + opq_off(BAR_OFF + 65536)))
    float* X = p.out;
    if (mk_tid(wv) == 0) __hip_atomic_fetch_add(barctr + 64 * (1 + xcc_id()), 1u, __ATOMIC_RELAXED, __HIP_MEMORY_SCOPE_AGENT);
#define PH_BEGIN if (ph >= p.ph_lo && ph < p.ph_hi) {
#define PH_END   if (ph + 1 < p.ph_hi) { if (ph == p.ph_lo) { grid.sync(); \
        if (mk_tid(wv) == 0) { unsigned nx_ = __hip_atomic_load(barctr + 64 * (1 + xcc_id()), __ATOMIC_RELAXED, __HIP_MEMORY_SCOPE_AGENT), nxcc_ = 0; \
            for (int x_ = 0; x_ < 16; ++x_) nxcc_ += __hip_atomic_load(barctr + 64 * (1 + x_), __ATOMIC_RELAXED, __HIP_MEMORY_SCOPE_AGENT) != 0u ? 1u : 0u; \
            stash[0] = nx_; stash[1] = nxcc_; } } \
        else { ++nbar; grid_barrier(wv, barctr, nbar, stash); } } } ++ph;
    PH_BEGIN
        xconvert(wv, p.in[0], xb);
        wprep_layer(wv, lds, p, 0, wb);
    PH_END
#pragma nounroll
    for (int layer = 0; layer < 4; ++layer) {
        const int kind = layer % 3, ib = layer_base(layer), wo = wout_idx(layer);
        const int nin = kind == 1 ? 9216 : 3072;
        bf16_t* wb_out = wb + (size_t)nin * 1024; bf16_t* wb_1 = wb_out + 1024 * 1024; bf16_t* wb_2 = wb_1 + 4096 * 1024;
        bf16_t* QK = (bf16_t*)scr;
        bf16_t* VT = (bf16_t*)(scr + (kind == 2 ? 192 : 128) * MiB);
        bf16_t* OB = (bf16_t*)(scr + 192 * MiB);
        float* OACC = (float*)(scr + 256 * MiB); float* STATS = (float*)(scr + 384 * MiB);
        bf16_t* KI = (bf16_t*)(scr + 64 * MiB); float* OBUF = (float*)scr; bf16_t* RB = (bf16_t*)(scr + 128 * MiB);
        bf16_t* QD = (bf16_t*)(scr + 256 * MiB); bf16_t* KST = (bf16_t*)(scr + 288 * MiB); bf16_t* SB = (bf16_t*)(scr + 320 * MiB); float* DEC = (float*)(scr + 336 * MiB);
        bf16_t* H = (bf16_t*)scr;
        const int ng = kind == 1 ? 3 : 1;
#pragma nounroll
        for (int g = 0; g < ng; ++g) {
            const int dil = kind == 1 ? (g == 0 ? 1 : g == 1 ? 4 : 16) : 1;
            PH_BEGIN
                const int ngemm = kind == 2 ? 3 : 2;
#pragma nounroll
                for (int rep = 0; rep < REP_MIXG; ++rep)
#pragma nounroll
                for (int gi = 0; gi < ngemm; ++gi) {
                    GemmD d; EpiBf16<0> E;
                    d.K = 1024; d.dil = 1; d.L = 4096;
                    const bf16_t* wg_ = wb + (size_t)g * 3072 * 1024;
                    const bool isvt = (gi == ngemm - 1);
                    if (!isvt) {
                        d.A = xb; d.lda = 1024; d.ldb = 1024; d.nM = 128;
                        if (kind == 2) { d.Bt = wg_ + (size_t)(gi == 0 ? 0 : 2048) * 1024; d.nN = 4; E.O = gi == 0 ? QK : RB; E.ldc = 1024; }
                        else { d.Bt = wg_; d.nN = 8; E.O = QK; E.ldc = 2048; }
                    } else {
                        d.A = wg_ + (size_t)(kind == 2 ? 1024 : 2048) * 1024; d.lda = 1024; d.nM = 4;
                        d.Bt = xb; d.ldb = 1024; d.nN = 128; d.dil = dil; d.L = 4096 / dil; E.O = VT; E.ldc = M_TOK;
                    }
                    gemm_phase(wv, lds, d, E);
                }
            PH_END
            if (kind == 0) {
                PH_BEGIN
                    for (int rep = 0; rep < REP_DIFF; ++rep) diff_attn_phase(wv, lds, QK, VT, OB, p.in[ib + 1], p.in[ib + 2], p.in[ib + 3], p.in[ib + 4], p.in[ib + 5], layer);
                PH_END
            } else if (kind == 1) {
                PH_BEGIN
                    for (int rep = 0; rep < (g == 0 ? REP_DIL0 : 1); ++rep) { if (rep) __syncthreads(); dil_attn_phase(wv, QK, VT, OACC, STATS, OB, g, dil); }
                PH_END
            } else {
                PH_BEGIN
                    for (int rep = 0; rep < REP_GATE; ++rep) { if (rep) __syncthreads(); gla_gate_phase(wv, lds, X, p.in[ib], p.in[ib + 1], p.in[ib + 2], QK, QD, KI, KST, DEC, SB); }
                PH_END
                PH_BEGIN
                    for (int rep = 0; rep < REP_SCAN; ++rep) gla_scan_phase(wv, lds, QD, KST, SB, VT, DEC, OBUF);
                PH_END
                PH_BEGIN
                    gla_finish_phase(wv, OBUF, RB, p.in[ib + 3], OB);
                PH_END
            }
        }
#pragma nounroll
        for (int sub = 0; sub < 2; ++sub) {
            if (sub == 1) {
                PH_BEGIN
                    GemmD d; EpiBf16<1> E;
                    d.A = xb; d.lda = 1024; d.Bt = wb_1; d.ldb = 1024; d.K = 1024; d.nM = 128; d.nN = 16; d.dil = 1; d.L = 4096; E.O = H; E.ldc = 4096;
#pragma nounroll
                    for (int rep = 0; rep < REP_FFN1; ++rep) gemm_phase(wv, lds, d, E);
                PH_END
            }
            PH_BEGIN
                GemmD d; EpiBf16<0> E;
                d.A = sub == 0 ? OB : H; d.lda = sub == 0 ? 1024 : 4096; d.Bt = sub == 0 ? wb_out : wb_2; d.ldb = d.lda; d.K = d.lda; d.nM = 128; d.nN = 4; d.dil = 1; d.L = 4096;
                E.O = (bf16_t*)(scr + 256 * MiB); E.ldc = 1024;
                gemm_phase(wv, lds, d, E);
            PH_END
            PH_BEGIN
                ln_phase(wv, (const bf16_t*)(scr + 256 * MiB), ((layer == 3 || layer == 1) && sub == 1) ? X : nullptr, p.in[wo + 1 + 4 * sub], p.in[wo + 2 + 4 * sub], xb);
                if (sub == 1 && layer < 3) for (int rep = 0; rep < REP_PREP; ++rep) { if (rep) __syncthreads(); wprep_layer(wv, lds, p, layer + 1, wb); }
            PH_END
        }
    }
}

#undef xb
#undef wb
#undef scr
#undef barctr
#undef STT
extern "C" void kernel_launch(void* const* d_in, const int* in_sizes, int n_in, void* d_out, int out_size, void* d_ws, size_t ws_size, hipStream_t stream) {
    static int grid = 0;
    if (grid == 0) {
        if (n_in != 46 || ws_size < WS_NEED) { fprintf(stderr, "kernel_launch: unexpected n_in %d or ws_size %zu\n", n_in, ws_size); grid = -1; return; }
        int dev = 0, cus = 0, per_cu = 0;
        hipGetDevice(&dev);
        hipDeviceGetAttribute(&cus, hipDeviceAttributeMultiprocessorCount, dev);
        hipFuncSetAttribute((const void*)mega, hipFuncAttributeMaxDynamicSharedMemorySize, LDS_BYTES);
        hipOccupancyMaxActiveBlocksPerMultiprocessor(&per_cu, (const void*)mega, 512, LDS_BYTES);
        if (per_cu < 1) { fprintf(stderr, "kernel_launch: occupancy query says %d blocks per CU\n", per_cu); per_cu = 1; }
        (void)hipGetLastError();
        grid = cus * per_cu;
    }
    if (grid < 0) return;
    Params p{};
    for (int i = 0; i < 46; ++i) p.in[i] = (const float*)d_in[i];
    p.out = (float*)d_out; p.ws = (unsigned char*)d_ws;
#if MULTI_LAUNCH
    for (int ph = 0; ph < NPH; ++ph) { p.ph_lo = ph; p.ph_hi = ph + 1; hipLaunchKernelGGL(mega, dim3(grid), dim3(512), LDS_BYTES, stream, p); }
#else
    p.ph_lo = 0; p.ph_hi = NPH;
    (void)hipMemsetAsync((unsigned char*)d_ws + BAR_OFF, 0, 16384, stream);
    void* args[] = {&p};
    hipError_t e = hipLaunchCooperativeKernel((const void*)mega, dim3(grid), dim3(512), args, LDS_BYTES, stream);
    if (e != hipSuccess) fprintf(stderr, "cooperative launch failed: %s (grid %d)\n", hipGetErrorString(e), grid);
#endif
}
```
